# Optimizing an MI355X kernel written in HIP

```python
import jax, jax.numpy as jnp
from jax import lax
import numpy as np

D_MODEL = 2048
BATCH = 2
SEQ = 4096
DEPTH = 2

N_HEADS = 16
Q_LORA = 512
KV_LORA = 256
QK_NOPE = 128
QK_ROPE = 64
V_HEAD = 128
QK_HEAD = QK_NOPE + QK_ROPE
ATTN_WIDTH = N_HEADS * V_HEAD
ROPE_THETA = 10000.0
Q_BLOCK = 128
CONV_WIDTH = 1024
CONV_K = 3
N_EXPERTS = 64
TOP_K = 8
N_GROUPS = 8
TOPK_GROUPS = 4
EXPERTS_PER_GROUP = N_EXPERTS // N_GROUPS
D_EXPERT = 512
D_SHARED = 512
ROUTED_SCALE = 2.5
ROW_BLOCK = 128
N_MOD = 6
EPS = 1e-6
IN_SIZES = (Q_LORA, KV_LORA, QK_ROPE, CONV_WIDTH, CONV_WIDTH, CONV_WIDTH, D_MODEL, D_MODEL)
N_IN = Q_LORA + KV_LORA + QK_ROPE + 3 * CONV_WIDTH + 2 * D_MODEL

kernel_name = 'hybrid_mla_shortconv_moe_adaln_encoder'


def rmsnorm(x, g):
    xf = x.astype(jnp.float32)
    y = xf * lax.rsqrt(jnp.mean(xf * xf, axis=-1, keepdims=True) + EPS)
    return (y * g.astype(jnp.float32)).astype(x.dtype)


def modulate(h, shift, scale):
    return h * (1 + scale[:, None, :]) + shift[:, None, :]


def rope_tables(positions, dtype):
    inv = 1.0 / (ROPE_THETA ** (jnp.arange(0, QK_ROPE, 2, dtype=jnp.float32) / QK_ROPE))
    ang = positions.astype(jnp.float32)[..., None] * inv
    return jnp.cos(ang).astype(dtype), jnp.sin(ang).astype(dtype)


def apply_rope(t, cos, sin):
    t1, t2 = jnp.split(t, 2, axis=-1)
    return jnp.concatenate([t1 * cos - t2 * sin, t2 * cos + t1 * sin], axis=-1)


def mla_attention(c_q, c_kv, k_pe_raw, cos, sin, g_q, w_uq, g_kv, w_ukv, w_o):
    b, s, _ = c_q.shape
    nb = s // Q_BLOCK
    q = jnp.einsum('bsr,rhd->bshd', rmsnorm(c_q, g_q), w_uq) * (QK_HEAD ** -0.5)
    q_nope = q[..., :QK_NOPE]
    q_pe = apply_rope(q[..., QK_NOPE:], cos[:, :, None, :], sin[:, :, None, :])
    kv = jnp.einsum('bsr,rhd->bshd', rmsnorm(c_kv, g_kv), w_ukv)
    k_nope, v = kv[..., :QK_NOPE], kv[..., QK_NOPE:]
    k_pe = apply_rope(k_pe_raw, cos, sin)

    def to_blocks(t):
        return t.reshape(b, nb, Q_BLOCK, *t.shape[2:]).swapaxes(0, 1)

    def attend(blk):
        qn, qp = blk
        sc = (jnp.einsum('bqhd,bkhd->bhqk', qn, k_nope)
              + jnp.einsum('bqhr,bkr->bhqk', qp, k_pe))
        p = jax.nn.softmax(sc.astype(jnp.float32), axis=-1).astype(v.dtype)
        return jnp.einsum('bhqk,bkhd->bqhd', p, v)

    o = lax.map(attend, (to_blocks(q_nope), to_blocks(q_pe)))
    o = o.swapaxes(0, 1).reshape(b, s, ATTN_WIDTH)
    return o @ w_o


def short_conv(gate_b, gate_c, u, conv_w, w_conv_out):
    z = gate_c * u
    z = lax.conv_general_dilated(z, conv_w, window_strides=(1,), padding=((1, 1),),
                                 dimension_numbers=('NWC', 'WIO', 'NWC'),
                                 feature_group_count=CONV_WIDTH)
    return (gate_b * z) @ w_conv_out


def swiglu(h, w1, w3, w2):
    return (jax.nn.silu(h @ w1) * (h @ w3)) @ w2


def route(h, w_router, b_router):
    t = h.shape[0]
    scores = jax.nn.sigmoid(h.astype(jnp.float32) @ w_router.astype(jnp.float32))
    biased = scores + b_router.astype(jnp.float32)
    grp_score = lax.top_k(biased.reshape(t, N_GROUPS, EXPERTS_PER_GROUP), 2)[0].sum(-1)
    _, grp_idx = lax.top_k(grp_score, TOPK_GROUPS)
    grp_mask = jnp.any(grp_idx[:, :, None] == jnp.arange(N_GROUPS)[None, None, :], axis=1)
    allowed = jnp.repeat(grp_mask, EXPERTS_PER_GROUP, axis=1)
    _, idx = lax.top_k(jnp.where(allowed, biased, -jnp.inf), TOP_K)
    wts = jnp.take_along_axis(scores, idx, axis=-1)
    wts = wts / jnp.sum(wts, axis=-1, keepdims=True) * ROUTED_SCALE
    return idx, wts


def routed_experts(h, idx, wts, w1, w3, w2):
    t, d = h.shape
    n_assign = t * TOP_K
    n_rows = n_assign + N_EXPERTS * ROW_BLOCK
    n_blk = n_rows // ROW_BLOCK
    flat_e = idx.reshape(-1)
    flat_t = jnp.repeat(jnp.arange(t, dtype=jnp.int32), TOP_K)
    flat_w = wts.reshape(-1)
    order = jnp.argsort(flat_e)
    se = flat_e[order]
    counts = jnp.bincount(flat_e, length=N_EXPERTS)
    start = jnp.cumsum(counts) - counts
    padded = (counts + ROW_BLOCK - 1) // ROW_BLOCK * ROW_BLOCK
    pend = jnp.cumsum(padded)
    pstart = pend - padded
    dest = pstart[se] + jnp.arange(n_assign, dtype=jnp.int32) - start[se]
    row_tok = jnp.full((n_rows,), t, jnp.int32).at[dest].set(flat_t[order])
    row_w = jnp.zeros((n_rows,), h.dtype).at[dest].set(flat_w[order].astype(h.dtype))
    blk_start = jnp.arange(n_blk, dtype=jnp.int32) * ROW_BLOCK
    blk_e = jnp.minimum(jnp.searchsorted(pend, blk_start, side='right'), N_EXPERTS - 1)
    h_pad = jnp.concatenate([h, jnp.zeros((1, d), h.dtype)], axis=0)

    def run(blk):
        e, tok = blk
        xb = h_pad[tok]
        return (jax.nn.silu(xb @ w1[e]) * (xb @ w3[e])) @ w2[e]

    out = lax.map(run, (blk_e, row_tok.reshape(n_blk, ROW_BLOCK)))
    out = out.reshape(n_rows, d) * row_w[:, None]
    return jnp.zeros((t + 1, d), h.dtype).at[row_tok].add(out)[:t]


def setup_inputs(seed: int = 0) -> dict:
    key = jax.random.key(seed)
    ks = jax.random.split(key, 25)
    L, D = DEPTH, D_MODEL

    def w(k, shape, fan_in, gain=1.0):
        return jax.random.normal(k, shape, jnp.float32) * (gain * fan_in ** -0.5)

    def g(k, shape):
        return 1.0 + 0.02 * jax.random.normal(k, shape, jnp.float32)

    offset = jax.random.randint(ks[2], (BATCH, 1), 0, 1024, dtype=jnp.int32)
    positions = offset + jnp.arange(SEQ, dtype=jnp.int32)[None, :]
    return {
        'x': jax.random.normal(ks[0], (BATCH, SEQ, D), jnp.float32),
        'c': jax.random.normal(ks[1], (BATCH, D), jnp.float32),
        'positions': positions,
        'w_ada': w(ks[3], (L, D, N_MOD * D), D, 0.5),
        'b_ada': 0.02 * jax.random.normal(ks[4], (L, N_MOD * D), jnp.float32),
        'g_mix': g(ks[5], (L, D)),
        'w_in': w(ks[6], (L, D, N_IN), D),
        'g_q': g(ks[7], (L, Q_LORA)),
        'w_uq': w(ks[8], (L, Q_LORA, N_HEADS, QK_HEAD), Q_LORA),
        'g_kv': g(ks[9], (L, KV_LORA)),
        'w_ukv': w(ks[10], (L, KV_LORA, N_HEADS, QK_NOPE + V_HEAD), KV_LORA),
        'w_o_attn': w(ks[11], (L, ATTN_WIDTH, D), ATTN_WIDTH),
        'conv_w': w(ks[12], (L, CONV_K, 1, CONV_WIDTH), CONV_K),
        'w_conv_out': w(ks[13], (L, CONV_WIDTH, D), CONV_WIDTH),
        'w_out': w(ks[14], (L, D, D), D),
        'g_ffn': g(ks[15], (L, D)),
        'w_router': w(ks[16], (L, D, N_EXPERTS), D),
        'b_router': 0.01 * jax.random.normal(ks[17], (L, N_EXPERTS), jnp.float32),
        'w1_e': w(ks[18], (L, N_EXPERTS, D, D_EXPERT), D),
        'w3_e': w(ks[19], (L, N_EXPERTS, D, D_EXPERT), D),
        'w2_e': w(ks[20], (L, N_EXPERTS, D_EXPERT, D), D_EXPERT),
        'w1_s': w(ks[21], (L, D, D_SHARED), D),
        'w3_s': w(ks[22], (L, D, D_SHARED), D),
        'w2_s': w(ks[23], (L, D_SHARED, D), D_SHARED),
        'g_final': g(ks[24], (D,)),
    }


def reference(x, c, positions, w_ada, b_ada, g_mix, w_in, g_q, w_uq, g_kv, w_ukv,
              w_o_attn, conv_w, w_conv_out, w_out, g_ffn, w_router, b_router,
              w1_e, w3_e, w2_e, w1_s, w3_s, w2_s, g_final):
    b, s, d = x.shape
    cos, sin = rope_tables(positions, x.dtype)
    c_act = jax.nn.silu(c)
    split_at = np.cumsum(IN_SIZES)[:-1].tolist()
    for i in range(DEPTH):
        mod = c_act @ w_ada[i] + b_ada[i]
        sh_m, sc_m, gt_m, sh_f, sc_f, gt_f = jnp.split(mod, N_MOD, axis=-1)

        h = modulate(rmsnorm(x, g_mix[i]), sh_m, sc_m)
        (c_q, c_kv, k_pe_raw, gate_b, gate_c, u,
         logit_a, logit_c) = jnp.split(h @ w_in[i], split_at, axis=-1)
        y_attn = mla_attention(c_q, c_kv, k_pe_raw, cos, sin, g_q[i], w_uq[i],
                               g_kv[i], w_ukv[i], w_o_attn[i])
        y_conv = short_conv(gate_b, gate_c, u, conv_w[i], w_conv_out[i])
        y = (jax.nn.sigmoid(logit_a) * y_attn + jax.nn.sigmoid(logit_c) * y_conv) @ w_out[i]
        x = x + gt_m[:, None, :] * y

        h = modulate(rmsnorm(x, g_ffn[i]), sh_f, sc_f).reshape(b * s, d)
        idx, wts = route(h, w_router[i], b_router[i])
        y = (routed_experts(h, idx, wts, w1_e[i], w3_e[i], w2_e[i])
             + swiglu(h, w1_s[i], w3_s[i], w2_s[i]))
        x = x + gt_f[:, None, :] * y.reshape(b, s, d)
    return rmsnorm(x, g_final)
```

```cpp
#include <hip/hip_runtime.h>
#include <cstdio>
#include <cstdint>
#include <cmath>

#define LAS __attribute__((address_space(3)))
#define GAS __attribute__((address_space(1)))
typedef unsigned short bf16;
typedef short bf16x8 __attribute__((ext_vector_type(8)));
typedef short s16x4 __attribute__((ext_vector_type(4)));
typedef float f32x4 __attribute__((ext_vector_type(4)));
typedef float f32x2 __attribute__((ext_vector_type(2)));
typedef float f32x16 __attribute__((ext_vector_type(16)));
typedef unsigned u32x4 __attribute__((ext_vector_type(4)));
typedef unsigned u32x2 __attribute__((ext_vector_type(2)));

constexpr int DM = 2048, NB = 2, SEQ = 4096, NT = NB * SEQ, DEPTH = 2;
constexpr int NH = 16, QL = 512, KVL = 256, DNOPE = 128, DROPE = 64, DV = 128, DQK = 192;
constexpr int CW = 1024, NE = 64, TOPK = 8, DE = 512, DS = 512;
constexpr int NIN = 8000, NINP = 8192;
constexpr int NMOD = 6;
constexpr float EPS = 1e-6f;
constexpr int NWAVES = 8, NTHREADS = 512;
constexpr int PC_CQ = 0, PC_CKV = 512, PC_KPE = 768, PC_GB = 1024, PC_GC = 2048, PC_U = 3072, PC_LA = 4096, PC_LC = 6144;
constexpr int MAXROWS = 65536 + 64 * 256;
constexpr int WSR_ROWS = 1280;

constexpr size_t MiB = 1u << 20;
constexpr size_t WS_CTL = 0, CTL_BYTES = 1 * MiB;
constexpr size_t WS_CS = 2 * MiB;
constexpr size_t WS_WIN = 4 * MiB;
constexpr size_t WS_WUQ = WS_WIN + 64 * MiB;
constexpr size_t WS_WUKV = WS_WUQ + 6 * MiB;
constexpr size_t WS_WO = WS_WUKV + 4 * MiB;
constexpr size_t WS_WCO = WS_WO + 16 * MiB;
constexpr size_t WS_WOUT = WS_WCO + 8 * MiB;
constexpr size_t WS_WSR = WS_WOUT + 16 * MiB;
constexpr size_t WS_W2S = WS_WSR + 10 * MiB;
constexpr size_t WS_W13E = WS_W2S + 4 * MiB;
constexpr size_t WS_W2E = WS_W13E + 512 * MiB;
constexpr size_t WS_WSH8 = WS_W2E + 128 * MiB;
constexpr size_t WS_H8 = WS_W2E + 136 * MiB;
constexpr size_t WS_WIN8 = WS_W2E + 160 * MiB;
constexpr size_t WS_WO8 = WS_W2E + 192 * MiB;
constexpr size_t WS_WOUT8 = WS_W2E + 200 * MiB;
constexpr size_t WS_O8 = WS_W2E + 208 * MiB;
constexpr size_t WS_MIX8 = WS_W2E + 224 * MiB;
constexpr size_t WS_X = WS_W2E + 256 * MiB;
constexpr size_t WS_H = WS_X + 64 * MiB;
constexpr size_t WS_T = WS_H + 32 * MiB;
constexpr size_t WS_PROJ = WS_T;
constexpr size_t WS_CQN = WS_PROJ + 128 * MiB;
constexpr size_t WS_CKVN = WS_CQN + 8 * MiB;
constexpr size_t WS_CZ = WS_CKVN + 4 * MiB;
constexpr size_t WS_Q = WS_CZ + 16 * MiB;
constexpr size_t WS_K = WS_Q + 48 * MiB;
constexpr size_t WS_V = WS_K + 48 * MiB;
constexpr size_t WS_O = WS_V + 32 * MiB;
constexpr size_t WS_M1 = WS_O + 32 * MiB;
constexpr size_t WS_MIX = WS_M1 + 32 * MiB;
constexpr size_t WS_MIXER_END = WS_MIX + 32 * MiB;
constexpr size_t WS_SACT = WS_T;
constexpr size_t WS_LOGIT = WS_SACT + 8 * MiB;
constexpr size_t WS_LIST = WS_LOGIT + 2 * MiB;
constexpr size_t WS_ASG = WS_LIST + 2 * MiB;
constexpr size_t WS_ACT = WS_ASG + 1 * MiB;
constexpr size_t WS_OUT2 = WS_ACT + 80 * MiB;
constexpr size_t WS_MOE_END = WS_OUT2 + (size_t)(MAXROWS + NT) * DM * 2;
constexpr size_t WS_END = (WS_MOE_END > WS_MIXER_END ? WS_MOE_END : WS_MIXER_END);
constexpr int CW_BAR = 4096;
constexpr int CW_WQ = 7680;
constexpr int CW_CNT = 8192;
constexpr int CW_MOD = 16384;
static_assert((CW_MOD + DEPTH * NB * NMOD * DM) * 4 <= (int)CTL_BYTES, "ctl");

constexpr int RING_BYTES = 131072;
constexpr int LDS_TAB = RING_BYTES;
constexpr int LDS_BYTES = 147456;

#define LDS_WAIT() asm volatile("s_waitcnt lgkmcnt(0)" ::: "memory")
#define VM_WAIT() asm volatile("s_waitcnt vmcnt(0)" ::: "memory")
#define RLX_AGENT __ATOMIC_RELAXED, __HIP_MEMORY_SCOPE_AGENT

__device__ __forceinline__ unsigned cvtpk(float lo, float hi) { unsigned r; asm volatile("v_cvt_pk_bf16_f32 %0, %1, %2" : "=v"(r) : "v"(lo), "v"(hi)); return r; }
__device__ __forceinline__ float bflo(unsigned w) { return __uint_as_float(w << 16); }
__device__ __forceinline__ float bfhi(unsigned w) { return __uint_as_float(w & 0xffff0000u); }
__device__ __forceinline__ float sigmoidf_(float v) { return __builtin_amdgcn_rcpf(1.0f + __expf(-v)); }
__device__ __forceinline__ float siluf_(float v) { return v * sigmoidf_(v); }
__device__ __forceinline__ int otid() { int t = threadIdx.x; asm volatile("" : "+v"(t)); return t; }
template <int CTRL> __device__ __forceinline__ float dpp_f(float v) { return __int_as_float(__builtin_amdgcn_update_dpp(0, __float_as_int(v), CTRL, 0xf, 0xf, true)); }
__device__ __forceinline__ float readlane_f(float v, int l) { return __int_as_float(__builtin_amdgcn_readlane(__float_as_int(v), l)); }
__device__ __forceinline__ float wave_sum(float v) {
    v += dpp_f<0xB1>(v); v += dpp_f<0x4E>(v); v += dpp_f<0x141>(v); v += dpp_f<0x140>(v);
    return (readlane_f(v, 0) + readlane_f(v, 16)) + (readlane_f(v, 32) + readlane_f(v, 48));
}

#define XB_TMO      128
#define XB_XCNT(j)  (256  + 64 * (j))
#define XB_XSUB(j)  (1280 + 64 * (j))
#define XB_XGEN(j)  (2304 + 64 * (j))
#define XB_TOP      3328
#define XB_TOPGEN   3392
#define XCD_BAR_WORDS 3456
#define XB_SPIN_CAP (1u << 22)

__device__ __forceinline__ unsigned xb_ld(unsigned* p)              { return __hip_atomic_load(p, __ATOMIC_RELAXED, __HIP_MEMORY_SCOPE_AGENT); }
__device__ __forceinline__ unsigned xb_add(unsigned* p, unsigned v) { return __hip_atomic_fetch_add(p, v, __ATOMIC_RELAXED, __HIP_MEMORY_SCOPE_AGENT); }
__device__ __forceinline__ unsigned xb_xcc_id() { return (unsigned)__builtin_amdgcn_s_getreg((3 << 11) | 20) & 0xFu; }
#define XB_SPIN(cond, bar) do { unsigned _sp = 0; while (cond) { __builtin_amdgcn_s_sleep(1); \
    if ((++_sp & 255u) == 0u) { if (xb_ld(&(bar)[XB_TMO])) break; if (_sp > XB_SPIN_CAP) { atomicAdd(&(bar)[XB_TMO], 1u); break; } } } } while (0)

struct XcdBarrier { unsigned* bar; unsigned x; volatile LAS unsigned* st; };

__device__ __forceinline__ XcdBarrier xcd_barrier_post(unsigned* bar, volatile LAS unsigned* st) {
    XcdBarrier b; b.bar = bar; b.x = xb_xcc_id(); b.st = st;
    if (otid() == 0) (void)xb_add(&bar[XB_XCNT(b.x)], 1u);
    return b;
}
__device__ __forceinline__ void xcd_barrier_complete(unsigned* bar, unsigned x, unsigned& nloc, unsigned& nx) {
    const unsigned G = gridDim.x * gridDim.y * gridDim.z;
    unsigned sum, cnt, mine, sp = 0u;
    for (;;) {
        sum = 0u; cnt = 0u; mine = 0u;
#pragma unroll
        for (unsigned j = 0; j < 16; ++j) { const unsigned c = xb_ld(&bar[XB_XCNT(j)]); sum += c; cnt += (c > 0u) ? 1u : 0u; mine = (j == x) ? c : mine; }
        if (sum == G) break;
        __builtin_amdgcn_s_sleep(1);
        if ((++sp & 255u) == 0u) { if (xb_ld(&bar[XB_TMO])) break; if (sp > XB_SPIN_CAP) { atomicAdd(&bar[XB_TMO], 1u); break; } }
    }
    nloc = mine > 0u ? mine : 1u; nx = cnt > 0u ? cnt : 1u;
}
__device__ __forceinline__ void xcd_barrier(const XcdBarrier& b) {
    asm volatile("s_waitcnt vmcnt(0)" ::: "memory");
    __syncthreads();
    if (otid() == 0) {
        unsigned* bar = b.bar;
        __builtin_amdgcn_s_waitcnt(0);
        unsigned nloc = b.st[0], nx = b.st[1];
        if (nloc == 0u) { xcd_barrier_complete(bar, b.x, nloc, nx); b.st[0] = nloc; b.st[1] = nx; }
        const unsigned old = xb_add(&bar[XB_XSUB(b.x)], 1u);
        const unsigned gen = old / nloc;
        if (old + 1u == (gen + 1u) * nloc) {
            __builtin_amdgcn_fence(__ATOMIC_RELEASE, "agent");
            asm volatile("s_waitcnt vmcnt(0)" ::: "memory");
            const unsigned og = xb_add(&bar[XB_TOP], 1u);
            const unsigned tg = og / nx;
            if (og + 1u == (tg + 1u) * nx) xb_add(&bar[XB_TOPGEN], 1u);
            else XB_SPIN(xb_ld(&bar[XB_TOPGEN]) == tg, bar);
            __builtin_amdgcn_fence(__ATOMIC_ACQUIRE, "agent");
            xb_add(&bar[XB_XGEN(b.x)], 1u);
            asm volatile("s_waitcnt vmcnt(0)" ::: "memory");
        } else {
            XB_SPIN(xb_ld(&bar[XB_XGEN(b.x)]) == gen, bar);
            __builtin_amdgcn_fence(__ATOMIC_ACQUIRE, "agent");
            asm volatile("s_waitcnt vmcnt(0)" ::: "memory");
        }
    }
    __syncthreads();
}

struct Args {
    const float* in[25];
    float* out; unsigned char* ws;
    int ph_lo, ph_hi;
};
__device__ const float inv_freq_tab[32] = {1.000000000e+00f, 7.498942018e-01f, 5.623413324e-01f, 4.216965139e-01f, 3.162277639e-01f, 2.371373922e-01f, 1.778279394e-01f, 1.333521456e-01f, 1.000000015e-01f, 7.498941571e-02f, 5.623412877e-02f, 4.216964915e-02f, 3.162277862e-02f, 2.371373586e-02f, 1.778279431e-02f, 1.333521493e-02f, 9.999999776e-03f, 7.498942316e-03f, 5.623413250e-03f, 4.216964822e-03f, 3.162277862e-03f, 2.371373819e-03f, 1.778279431e-03f, 1.333521446e-03f, 1.000000047e-03f, 7.498941850e-04f, 5.623413017e-04f, 4.216965463e-04f, 3.162277862e-04f, 2.371373848e-04f, 1.778279402e-04f, 1.333521504e-04f};
typedef const __attribute__((address_space(4))) Args CArgs;
enum { I_X = 0, I_C, I_POS, I_WADA, I_BADA, I_GMIX, I_WIN, I_GQ, I_WUQ, I_GKV, I_WUKV, I_WOA, I_CONVW, I_WCO, I_WOUT, I_GFFN, I_WR, I_BR, I_W1E, I_W3E, I_W2E, I_W1S, I_W3S, I_W2S, I_GFIN };

namespace pg {
constexpr int BM = 256, BK = 64, HALF = 128, HTB = HALF * BK * 2;
__device__ __forceinline__ int lds_byte(int r, int c) { return r * 128 + ((((c >> 3) ^ ((r >> 1) & 7))) << 4) + (c & 7) * 2; }
__device__ __forceinline__ void stage_rc(int b, int& R, int& C) { R = b >> 7; C = ((((b & 127) >> 4) ^ ((R >> 1) & 7))) << 3; }
__device__ __forceinline__ int perm32(int rho) { const int n = rho >> 4, i = rho & 15; return 8 * (i >> 2) + 4 * n + (i & 3); }
struct Unit { int pm, pn, aux, aux2, half; };
typedef f32x4 Acc[2][2][4][2];

template <class T, class = void> struct peel_of { static constexpr bool value = false; };
template <class T> struct peel_of<T, decltype((void)T::PEEL)> { static constexpr bool value = T::PEEL; };
template <class T, class = void> struct bmode_of { static constexpr int value = 0; };
template <class T> struct bmode_of<T, decltype((void)T::BMODE)> { static constexpr int value = T::BMODE; };
struct NoChainP { static constexpr int LDA = 0, LDB = 0; static constexpr bool FP8 = false, PERM = false, GATHER = false;
    __device__ __forceinline__ bool next(int, Unit&) const { return false; } __device__ __forceinline__ const char* a_base(const Unit&) const { return nullptr; } __device__ __forceinline__ const char* b_base(const Unit&) const { return nullptr; }
    __device__ __forceinline__ void a_offsets(const Unit&, unsigned (&)[2][2]) const {} };
struct NoChain { __device__ __forceinline__ NoChainP operator()() const { return NoChainP(); } };
template <class P, class MK = NoChain>
__device__ __forceinline__ void gemm_phase(LAS unsigned char* lds, const P& p, const MK& mk = MK(), bool chain_out = false, bool chained_in = false) {
    constexpr bool CHAIN = !__is_same(MK, NoChain);
    constexpr bool PEEL = peel_of<P>::value;
    constexpr bool FP8 = P::FP8; constexpr int ES = FP8 ? 1 : 2;
    constexpr int K = P::K, nt = K * ES / 128, LDA = P::LDA, LDB = P::LDB;
    static_assert((K * ES) % 256 == 0 && K * ES >= 512, "K");
    int tid = threadIdx.x; asm volatile("" : "+v"(tid));
    const int wid = __builtin_amdgcn_readfirstlane(tid >> 6), lane = tid & 63, wr = wid >> 2, wc = wid & 3, fr = lane & 15, fq = lane >> 4;
    unsigned voffB[2], vA[2][2], nvA[2][2], nvB[2]; typedef decltype(mk()) NP; constexpr int NES = NP::FP8 ? 1 : 2; constexpr int NBMODE = bmode_of<NP>::value; constexpr size_t nhstepB = (size_t)(NBMODE == 1 ? 8 : (NBMODE == 2 ? 16 : HALF)) * NP::LDB * NES;
    constexpr size_t kstep = (size_t)(BK * 2);
    constexpr int BMODE = bmode_of<P>::value;
    constexpr size_t hstep = (size_t)(BMODE == 1 ? 8 : (BMODE == 2 ? 16 : HALF)) * LDB * ES, hstepA = (size_t)HALF * LDA * ES;
#pragma unroll
    for (int i = 0; i < 2; ++i) { int R, C; stage_rc(tid * 16 + i * 8192, R, C); const int rho_ = R & 31;
        const int fq_ = (rho_ & 15) >> 2, n_ = rho_ >> 4, q_ = rho_ & 3;
        const int Rb = BMODE == 1 ? ((R >> 5) * 64 + fq_ * 16 + 4 * n_ + q_) : (BMODE == 2 ? ((R >> 5) * 64 + 32 * (fq_ >> 1) + 8 * n_ + 4 * (fq_ & 1) + q_) : (P::PERM ? ((R & ~31) + perm32(R & 31)) : R));
        voffB[i] = (unsigned)(Rb * LDB * ES + C * 2); vA[0][i] = (unsigned)(R * LDA * ES + C * 2); vA[1][i] = vA[0][i] + (unsigned)hstepA; nvA[0][i] = vA[0][i]; nvA[1][i] = vA[1][i]; nvB[i] = voffB[i]; }
    const unsigned ldsw = (unsigned)wid * 1024u;
    const int aoff = lds_byte(wr * 64 + fr, fq * 8), boff = lds_byte(wc * 32 + fr, fq * 8); const int aoff1 = aoff ^ 64, boff1 = boff ^ 64;
#define PG_SA(b, h) (((b) * 2 + (h)) * HTB)
#define PG_SB(b, h) ((4 + (b) * 2 + (h)) * HTB)
#define PG_STAGE(bufoff, gbase, voff) do { const char* gb_ = (const char*)(gbase); asm volatile("" : "+s"(gb_));     \
        _Pragma("unroll") for (int _i = 0; _i < 2; ++_i) \
        __builtin_amdgcn_global_load_lds((const unsigned*)(gb_ + (voff)[_i]), (LAS unsigned*)(lds + (bufoff) + ldsw + _i * 8192), 16, 0, 0); } while (0)
#define PG_LD8(p0_, p1_) __builtin_shufflevector(*(const LAS v4i_*)(p0_), *(const LAS v4i_*)(p1_), 0, 1, 2, 3, 4, 5, 6, 7)
#define PG_LDA(dst, b, h) do { if constexpr (FP8) { _Pragma("unroll") for (int m = 0; m < 4; ++m) dst##8[m] = PG_LD8(lds + PG_SA(b, h) + aoff + m * 2048, lds + PG_SA(b, h) + aoff1 + m * 2048); } \
        else { _Pragma("unroll") for (int m = 0; m < 4; ++m) _Pragma("unroll") for (int k = 0; k < 2; ++k) dst[m][k] = *(const LAS bf16x8*)(lds + PG_SA(b, h) + (k ? aoff1 : aoff) + m * 2048); } } while (0)
#define PG_LDB(dst, b, h) do { if constexpr (FP8) { _Pragma("unroll") for (int n = 0; n < 2; ++n) dst##8[n] = PG_LD8(lds + PG_SB(b, h) + boff + n * 2048, lds + PG_SB(b, h) + boff1 + n * 2048); } \
        else { _Pragma("unroll") for (int n = 0; n < 2; ++n) _Pragma("unroll") for (int k = 0; k < 2; ++k) dst[n][k] = *(const LAS bf16x8*)(lds + PG_SB(b, h) + (k ? boff1 : boff) + n * 2048); } } while (0)
#define PG_MMA(ai, bj, At, Bt) do { __builtin_amdgcn_s_setprio(1); _Pragma("unroll") for (int m = 0; m < 4; ++m) _Pragma("unroll") for (int n = 0; n < 2; ++n) { \
        if constexpr (FP8) acc[ai][bj][m][n] = __builtin_amdgcn_mfma_scale_f32_16x16x128_f8f6f4(Bt##8[n], At##8[m], acc[ai][bj][m][n], 0, 0, 0, 0, 0, 0); \
        else { _Pragma("unroll") for (int k = 0; k < 2; ++k) acc[ai][bj][m][n] = __builtin_amdgcn_mfma_f32_16x16x32_bf16(Bt[n][k], At[m][k], acc[ai][bj][m][n], 0, 0, 0); } } \
        __builtin_amdgcn_s_setprio(0); } while (0)
#define PG_MMAZ(ai, bj, At, Bt) do { const f32x4 z4_ = {0.f, 0.f, 0.f, 0.f}; __builtin_amdgcn_s_setprio(1); _Pragma("unroll") for (int m = 0; m < 4; ++m) _Pragma("unroll") for (int n = 0; n < 2; ++n) { \
        if constexpr (FP8) acc[ai][bj][m][n] = __builtin_amdgcn_mfma_scale_f32_16x16x128_f8f6f4(Bt##8[n], At##8[m], z4_, 0, 0, 0, 0, 0, 0); \
        else { acc[ai][bj][m][n] = __builtin_amdgcn_mfma_f32_16x16x32_bf16(Bt[n][0], At[m][0], z4_, 0, 0, 0); acc[ai][bj][m][n] = __builtin_amdgcn_mfma_f32_16x16x32_bf16(Bt[n][1], At[m][1], acc[ai][bj][m][n], 0, 0, 0); } } \
        __builtin_amdgcn_s_setprio(0); } while (0)
#define PG_WAIT_V(n) asm volatile("s_waitcnt vmcnt(" #n ")" ::: "memory")
#define PG_WAIT_L(n) asm volatile("s_waitcnt lgkmcnt(" #n ")" ::: "memory")
#define PG_BAR __builtin_amdgcn_s_barrier()
#define PG_SCHED __builtin_amdgcn_sched_barrier(0)
    Unit cur, nxt; int ui = 0;
    if (!p.next(0, cur)) return;
    Acc acc;
    if constexpr (!PEEL) {
#pragma unroll
    for (int a = 0; a < 2; ++a)
#pragma unroll
        for (int b = 0; b < 2; ++b)
#pragma unroll
            for (int m = 0; m < 4; ++m)
#pragma unroll
                for (int n = 0; n < 2; ++n) { typedef double d2_ __attribute__((ext_vector_type(2))); d2_ z_; asm volatile("v_mov_b64 %0, 0" : "=v"(z_.x)); asm volatile("v_mov_b64 %0, 0" : "=v"(z_.y)); acc[a][b][m][n] = __builtin_bit_cast(f32x4, z_); }
    }
    typedef int v8i_ __attribute__((ext_vector_type(8))); typedef int v4i_ __attribute__((ext_vector_type(4)));
    bf16x8 At[4][2], B0[2][2], B1[2][2]; v8i_ At8[4], B08[2], B18[2];
    const char* cA = p.a_base(cur); const char* cB = p.b_base(cur);
    if constexpr (P::GATHER) { p.a_offsets(cur, vA); }
    if (!chained_in) {
    PG_STAGE(PG_SB(0, 0), cB, voffB); PG_STAGE(PG_SA(0, 0), cA, vA[0]); PG_STAGE(PG_SB(0, 1), cB + hstep, voffB); PG_STAGE(PG_SA(0, 1), cA, vA[1]);
    if (wr == 1) PG_BAR;
    PG_WAIT_V(4); PG_BAR;
    PG_STAGE(PG_SB(1, 0), cB + kstep, voffB); PG_STAGE(PG_SA(1, 0), cA + kstep, vA[0]); PG_STAGE(PG_SB(1, 1), cB + hstep + kstep, voffB);
    PG_WAIT_V(6); PG_BAR;
    }
    for (;;) {
        const bool has_next = p.next(ui + 1, nxt);
        const char* nA = has_next ? p.a_base(nxt) : cA; const char* nB = has_next ? p.b_base(nxt) : cB;
        const bool chain_now = CHAIN && chain_out && !has_next;
        if constexpr (CHAIN) { if (chain_now) { const auto np = mk(); Unit nu; (void)np.next(0, nu); nA = np.a_base(nu); nB = np.b_base(nu); } }
        const bool full = P::HALF ? (cur.half == 0) : true;
#define PG_STAGE_A2(bufoff, gbase, h) do { if ((P::GATHER && last) || chl) PG_STAGE(bufoff, gbase, nvA[h]); else PG_STAGE(bufoff, gbase, vA[h]); } while (0)
#define PG_STAGE_B2(bufoff, gbase, h) do { if (chl) PG_STAGE(bufoff, (gbase) + (h) * nhstepB, nvB); else PG_STAGE(bufoff, (gbase) + (h) * hstep, voffB); } while (0)
        if constexpr (PEEL) {
            constexpr int t = 0;
            const bool last = (t == nt - 2);
            const char* a1 = cA + (size_t)(t + 1) * kstep;
            const char* a2 = last ? nA : cA + (size_t)(t + 2) * kstep; const char* b2 = last ? nB : cB + (size_t)(t + 2) * kstep;
            const char* a3 = a2 + kstep; const char* b3 = b2 + kstep;
            if constexpr (P::GATHER) {
                if (last && has_next) p.a_offsets(nxt, nvA);
                if (last && !has_next && !chain_now) {
#pragma unroll
                    for (int h = 0; h < 2; ++h)
#pragma unroll
                        for (int i = 0; i < 2; ++i) nvA[h][i] = vA[h][i]; }
            }
            if constexpr (CHAIN) {
                if (last && chain_now) {
                    if constexpr (NP::GATHER) { const auto np = mk(); Unit nu; (void)np.next(0, nu); np.a_offsets(nu, nvA); }
#pragma unroll
                    for (int i = 0; i < 2; ++i) { int R, C; stage_rc(tid * 16 + i * 8192, R, C); const int rho_ = R & 31, fq_ = (rho_ & 15) >> 2, n_ = rho_ >> 4, q_ = rho_ & 3;
                        const int Rb = NBMODE == 1 ? ((R >> 5) * 64 + fq_ * 16 + 4 * n_ + q_) : (NBMODE == 2 ? ((R >> 5) * 64 + 32 * (fq_ >> 1) + 8 * n_ + 4 * (fq_ & 1) + q_) : (NP::PERM ? ((R & ~31) + perm32(R & 31)) : R));
                        nvB[i] = (unsigned)(Rb * NP::LDB * NES + C * 2);
                        if constexpr (!NP::GATHER) { nvA[0][i] = (unsigned)(R * NP::LDA * NES + C * 2); nvA[1][i] = nvA[0][i] + (unsigned)((size_t)HALF * NP::LDA * NES); } }
                }
            }
            const bool chl = CHAIN && last && chain_now;
            PG_LDB(B0, 0, 0); PG_SCHED; PG_LDA(At, 0, 0); PG_STAGE(PG_SA(1, 1), a1, vA[1]);
            PG_WAIT_L(8); PG_BAR; PG_WAIT_L(0); PG_MMAZ(0, 0, At, B0); PG_BAR; PG_SCHED;
            PG_LDB(B1, 0, 1); PG_STAGE_B2(PG_SB(0, 0), b2, 0);
            PG_BAR; PG_WAIT_L(0); PG_MMAZ(0, 1, At, B1); PG_BAR;
            if (full) PG_LDA(At, 0, 1); PG_STAGE_A2(PG_SA(0, 0), a2, 0);
            PG_BAR; PG_WAIT_L(0); if (full) PG_MMAZ(1, 0, At, B0); PG_BAR; PG_SCHED;
            PG_STAGE_B2(PG_SB(0, 1), b2, 1);
            PG_WAIT_V(6); PG_BAR; if (full) PG_MMAZ(1, 1, At, B1); PG_BAR;
            PG_LDB(B0, 1, 0); PG_SCHED; PG_LDA(At, 1, 0); PG_STAGE_A2(PG_SA(0, 1), a2, 1);
            PG_WAIT_L(8); PG_BAR; PG_WAIT_L(0); PG_MMA(0, 0, At, B0); PG_BAR; PG_SCHED;
            PG_LDB(B1, 1, 1); PG_STAGE_B2(PG_SB(1, 0), b3, 0);
            PG_BAR; PG_WAIT_L(0); PG_MMA(0, 1, At, B1); PG_BAR;
            if (full) PG_LDA(At, 1, 1); PG_STAGE_A2(PG_SA(1, 0), a3, 0);
            PG_BAR; PG_WAIT_L(0); if (full) PG_MMA(1, 0, At, B0); PG_BAR; PG_SCHED;
            PG_STAGE_B2(PG_SB(1, 1), b3, 1);
            PG_WAIT_V(6); PG_BAR; if (full) PG_MMA(1, 1, At, B1); PG_BAR;

        }
#pragma nounroll
        for (int t = PEEL ? 2 : 0; t < nt; t += 2) {
            const bool last = (t == nt - 2);
            const char* a1 = cA + (size_t)(t + 1) * kstep;
            const char* a2 = last ? nA : cA + (size_t)(t + 2) * kstep; const char* b2 = last ? nB : cB + (size_t)(t + 2) * kstep;
            const char* a3 = a2 + kstep; const char* b3 = b2 + kstep;
            if constexpr (P::GATHER) {
                if (last && has_next) p.a_offsets(nxt, nvA);
                if (last && !has_next && !chain_now) {
#pragma unroll
                    for (int h = 0; h < 2; ++h)
#pragma unroll
                        for (int i = 0; i < 2; ++i) nvA[h][i] = vA[h][i]; }
            }
            if constexpr (CHAIN) {
                if (last && chain_now) {
                    if constexpr (NP::GATHER) { const auto np = mk(); Unit nu; (void)np.next(0, nu); np.a_offsets(nu, nvA); }
#pragma unroll
                    for (int i = 0; i < 2; ++i) { int R, C; stage_rc(tid * 16 + i * 8192, R, C); const int rho_ = R & 31, fq_ = (rho_ & 15) >> 2, n_ = rho_ >> 4, q_ = rho_ & 3;
                        const int Rb = NBMODE == 1 ? ((R >> 5) * 64 + fq_ * 16 + 4 * n_ + q_) : (NBMODE == 2 ? ((R >> 5) * 64 + 32 * (fq_ >> 1) + 8 * n_ + 4 * (fq_ & 1) + q_) : (NP::PERM ? ((R & ~31) + perm32(R & 31)) : R));
                        nvB[i] = (unsigned)(Rb * NP::LDB * NES + C * 2);
                        if constexpr (!NP::GATHER) { nvA[0][i] = (unsigned)(R * NP::LDA * NES + C * 2); nvA[1][i] = nvA[0][i] + (unsigned)((size_t)HALF * NP::LDA * NES); } }
                }
            }
            const bool chl = CHAIN && last && chain_now;
            PG_LDB(B0, 0, 0); PG_SCHED; PG_LDA(At, 0, 0); PG_STAGE(PG_SA(1, 1), a1, vA[1]);
            PG_WAIT_L(8); PG_BAR; PG_WAIT_L(0); PG_MMA(0, 0, At, B0); PG_BAR; PG_SCHED;
            PG_LDB(B1, 0, 1); PG_STAGE_B2(PG_SB(0, 0), b2, 0);
            PG_BAR; PG_WAIT_L(0); PG_MMA(0, 1, At, B1); PG_BAR;
            if (full) PG_LDA(At, 0, 1); PG_STAGE_A2(PG_SA(0, 0), a2, 0);
            PG_BAR; PG_WAIT_L(0); if (full) PG_MMA(1, 0, At, B0); PG_BAR; PG_SCHED;
            PG_STAGE_B2(PG_SB(0, 1), b2, 1);
            PG_WAIT_V(6); PG_BAR; if (full) PG_MMA(1, 1, At, B1); PG_BAR;
            PG_LDB(B0, 1, 0); PG_SCHED; PG_LDA(At, 1, 0); PG_STAGE_A2(PG_SA(0, 1), a2, 1);
            PG_WAIT_L(8); PG_BAR; PG_WAIT_L(0); PG_MMA(0, 0, At, B0); PG_BAR; PG_SCHED;
            PG_LDB(B1, 1, 1); PG_STAGE_B2(PG_SB(1, 0), b3, 0);
            PG_BAR; PG_WAIT_L(0); PG_MMA(0, 1, At, B1); PG_BAR;
            if (full) PG_LDA(At, 1, 1); PG_STAGE_A2(PG_SA(1, 0), a3, 0);
            PG_BAR; PG_WAIT_L(0); if (full) PG_MMA(1, 0, At, B0); PG_BAR; PG_SCHED;
            PG_STAGE_B2(PG_SB(1, 1), b3, 1);
            PG_WAIT_V(6); PG_BAR; if (full) PG_MMA(1, 1, At, B1); PG_BAR;

        }
        p.epi(acc, cur, wr, wc, fr, fq);
        if (!has_next) break;
    if constexpr (!PEEL) {
#pragma unroll
        for (int a = 0; a < 2; ++a)
#pragma unroll
            for (int b = 0; b < 2; ++b)
#pragma unroll
                for (int m = 0; m < 4; ++m)
#pragma unroll
                    for (int n = 0; n < 2; ++n) { typedef double d2_ __attribute__((ext_vector_type(2))); d2_ z_; asm volatile("v_mov_b64 %0, 0" : "=v"(z_.x)); asm volatile("v_mov_b64 %0, 0" : "=v"(z_.y)); acc[a][b][m][n] = __builtin_bit_cast(f32x4, z_); }
    }
        cur = nxt; cA = nA; cB = nB; ++ui;
        if constexpr (P::GATHER) {
#pragma unroll
            for (int h = 0; h < 2; ++h)
#pragma unroll
                for (int i = 0; i < 2; ++i) vA[h][i] = nvA[h][i]; }
    }
    if (!(CHAIN && chain_out)) {
    PG_WAIT_V(0);
    if (wr == 0) PG_BAR;
    PG_BAR;
    }
#undef PG_SA
#undef PG_SB
#undef PG_STAGE
#undef PG_STAGE_A2
#undef PG_STAGE_B2
#undef PG_LDA
#undef PG_LDB
#undef PG_MMA
#undef PG_MMAZ
#undef PG_WAIT_V
#undef PG_WAIT_L
#undef PG_BAR
#undef PG_SCHED
}
struct ListOrder {
    int nN, first, n;
    __device__ __forceinline__ bool get(int i, int& pm, int& pn) const { if (i >= n) return false; const int L = first + i; pm = L / nN; pn = L % nN; return true; }
};
struct GridOrder {
    int nM, nN, nwg, G, c;
    __device__ __forceinline__ void init(int nM_, int nN_, int G_, int c_) { nM = nM_; nN = nN_; nwg = nM * nN; G = G_; c = c_; }
    __device__ __forceinline__ bool get(int i, int& pm, int& pn) const {
        const long L = (long)i * G + c; if (L >= nwg) return false;
        int wgid = (int)L; { const int q = nwg / 8, r = nwg % 8, xcd = wgid % 8, off = wgid / 8; wgid = (xcd < r ? xcd * (q + 1) : r * (q + 1) + (xcd - r) * q) + off; }
        const int nig = 8 * nN, gid = wgid / nig, fm = gid * 8, gsz = (nM - fm) < 8 ? (nM - fm) : 8;
        pm = fm + ((wgid % nig) % gsz); pn = (wgid % nig) / gsz; return true;
    }
};
}

#ifndef FP8_WO
#define FP8_WO 1
#endif
#ifndef FP8_WOUT
#define FP8_WOUT 1
#endif
constexpr float W13_SCALE = 64.f, W2_SCALE = 32.f;
__device__ __forceinline__ u32x2 pack8_fp8(const f32x4 a, const f32x4 b) { int w0 = 0, w1 = 0; w0 = __builtin_amdgcn_cvt_pk_fp8_f32(a[0], a[1], w0, false); w0 = __builtin_amdgcn_cvt_pk_fp8_f32(a[2], a[3], w0, true);
    w1 = __builtin_amdgcn_cvt_pk_fp8_f32(b[0], b[1], w1, false); w1 = __builtin_amdgcn_cvt_pk_fp8_f32(b[2], b[3], w1, true); return (u32x2){(unsigned)w0, (unsigned)w1}; }
__device__ __forceinline__ void unpack8_fp8(const u32x2 w, f32x4& a, f32x4& b) { const f32x2 a0 = __builtin_amdgcn_cvt_pk_f32_fp8((int)w.x, false), a1 = __builtin_amdgcn_cvt_pk_f32_fp8((int)w.x, true), b0 = __builtin_amdgcn_cvt_pk_f32_fp8((int)w.y, false), b1 = __builtin_amdgcn_cvt_pk_f32_fp8((int)w.y, true);
    a = (f32x4){a0.x, a0.y, a1.x, a1.y}; b = (f32x4){b0.x, b0.y, b1.x, b1.y}; }
struct TrJob { const float* src; size_t sstride; int N, K; bf16* dst; size_t dstride; int nmats, mode, roff; };
__device__ __forceinline__ int tr_drow(int mode, int roff, int n) {
    if (mode == 1) { if (n < 768) return n; if (n < 832) { const int j = n - 768; return 768 + (j < 32 ? 2 * j : 2 * (j - 32) + 1); } return n + 192; }
    if (mode == 2) { const int d = n % 192; if (d < 128) return n; const int j = d - 128; return n - d + 128 + (j < 32 ? 2 * j : 2 * (j - 32) + 1); }
    if (mode == 6) {
        int d = n % 192; const int base = n - d; if (d >= 128) { const int j = d - 128; d = 128 + (j < 32 ? 2 * j : 2 * (j - 32) + 1); }
        const int s = d >> 6, hi = (d >> 5) & 1, b = (d >> 4) & 1, r = d & 15;
        return base + 64 * s + 32 * b + (r & 3) + 8 * (r >> 2) + 4 * hi; }
    if (mode == 3) return (n / 128) * 256 + (n % 128) + roff;
    if (mode == 4) return (n & 128) ? -1 : (n >> 8) * 128 + (n & 127);
    if (mode == 5) return (n & 128) ? (n >> 8) * 128 + (n & 127) : -1;
    return n + roff;
}
struct TrSlab { const float* src; unsigned char* dst; int N, ld, Kd, n0, mode, roff, fmt; };
__device__ __forceinline__ void cossin_d(double r, float& c, float& s) {
    const double r2 = r * r;
    double cs = 1.0, sn = 1.0;
    double tc = 0.0, ts = 0.0;
#pragma unroll
    for (int k = 14; k >= 1; --k) { tc = (1.0 - tc) * r2 / (double)((2 * k - 1) * (2 * k)); ts = (1.0 - ts) * r2 / (double)((2 * k) * (2 * k + 1)); }
    cs = 1.0 - tc; sn = r * (1.0 - ts);
    c = (float)cs; s = (float)sn;
}
constexpr int TR_NJOBS = 15;
constexpr int WIN_SPLIT = 3904;
__device__ const int TRT[TR_NJOBS][10] = {
    {I_W1E, DE, DM, DEPTH * NE, 3, 0, 1024, 64, 0, DE}, {I_W3E, DE, DM, DEPTH * NE, 3, 128, 1024, 64, 0, DE}, {I_W2E, DM, DE, DEPTH * NE, 0, 0, DM, 32, 0, DM},
    {I_WIN, NIN, DM, DEPTH, 1, 0, NINP, 0, 0, WIN_SPLIT}, {I_WIN, NIN, DM, DEPTH, 1, 0, NINP, 64, WIN_SPLIT, NIN},
    {I_WUQ, NH * DQK, QL, DEPTH, 6, 0, NH * DQK, 32, 0, NH * DQK}, {I_WUKV, NH * 256, KVL, DEPTH, 4, 0, NH * 128, 0, 0, NH * 256}, {I_WUKV, NH * 256, KVL, DEPTH, 5, 0, NH * 128, 0, 0, NH * 256},
    {I_WOA, DM, DM, DEPTH, 0, 0, DM, FP8_WO ? 64 : 0, 0, DM}, {I_WCO, DM, CW, DEPTH, 0, 0, DM, 0, 0, DM}, {I_WOUT, DM, DM, DEPTH, 0, 0, DM, FP8_WOUT ? 64 : 0, 0, DM},
    {I_W1S, DS, DM, DEPTH, 3, 0, 1024, 64, 0, DS}, {I_W3S, DS, DM, DEPTH, 3, 128, 1024, 64, 0, DS}, {I_WR, NE, DM, DEPTH, 0, 1024, WSR_ROWS, 0, 0, NE}, {I_W2S, DM, DS, DEPTH, 0, 0, DM, 32, 0, DM} };
__device__ const unsigned long long TRO[TR_NJOBS] = {WS_W13E, WS_W13E, WS_W2E, WS_WIN, WS_WIN8, WS_WUQ, WS_WUKV, WS_WUKV + 2 * MiB, FP8_WO ? WS_WO8 : WS_WO, WS_WCO, FP8_WOUT ? WS_WOUT8 : WS_WOUT, WS_WSH8, WS_WSH8, WS_WSR, WS_W2S};
__device__ __forceinline__ void prologue_phase(CArgs& A, LAS unsigned char* lds, int vcu, int G) {
    int tid = threadIdx.x; asm volatile("" : "+v"(tid));
    const int lane = tid & 63, wave = __builtin_amdgcn_readfirstlane(tid >> 6);
    const int gw = vcu * NWAVES + wave, NGW = G * NWAVES;
    unsigned char* ws = A.ws;
    LAS unsigned* scr = (LAS unsigned*)(lds + wave * 8320);
    if (blockIdx.x < DEPTH * (NMOD * DM / 256)) {
        constexpr int NJ = NMOD * DM / 256;
        const int l = blockIdx.x / NJ, jc = blockIdx.x % NJ;
        float* modacc = (float*)(ws + WS_CTL) + CW_MOD;
        const float* w = A.in[I_WADA] + ((size_t)l * DM + wave * 256) * (NMOD * DM) + jc * 256 + lane * 4;
        const float* c0 = A.in[I_C] + wave * 256; const float* c1 = c0 + DM;
        f32x4 a0 = {0.f, 0.f, 0.f, 0.f}, a1 = {0.f, 0.f, 0.f, 0.f};
#pragma unroll 8
        for (int k = 0; k < 256; ++k) { const f32x4 wv = *(const f32x4*)(w + (size_t)k * (NMOD * DM)); const float s0 = siluf_(c0[k]), s1 = siluf_(c1[k]); a0 += wv * s0; a1 += wv * s1; }
        LAS float* part = (LAS float*)(lds + 8 * 8320);
        *(LAS f32x4*)(part + (wave * 2 + 0) * 256 + lane * 4) = a0; *(LAS f32x4*)(part + (wave * 2 + 1) * 256 + lane * 4) = a1;
        __syncthreads();
        { const int b2 = tid >> 8, col = tid & 255; float sum = 0.f;
#pragma unroll
          for (int w8 = 0; w8 < 8; ++w8) sum += part[(w8 * 2 + b2) * 256 + col];
          modacc[((size_t)l * NB + b2) * (NMOD * DM) + jc * 256 + col] = sum + A.in[I_BADA][(size_t)l * (NMOD * DM) + jc * 256 + col]; }
        __syncthreads();
    }
    {
        const int lc = tid & 63, lk = tid >> 6, g4 = lane >> 4, li = lane & 15, lq = li >> 2, lp = li & 3;
        f32x4 v[16];
        TrSlab S; bool have = false;
        unsigned* wqh = (unsigned*)(ws + WS_CTL) + CW_WQ; LAS int* wql = (LAS int*)(lds + LDS_TAB + 128);
        int it;
        if (tid == 0) *wql = (int)atomicAdd(wqh, 1u);
        __syncthreads(); it = *wql;
#define TR_FIND(idx, out, found) do { int r_ = (idx); found = false; \
            for (int j_ = 0; j_ < TR_NJOBS; ++j_) { const int N_ = TRT[j_][1], K_ = TRT[j_][2], nm_ = TRT[j_][3], nb0_ = TRT[j_][8], ne_ = TRT[j_][9]; const int nn_ = (ne_ - nb0_ + 255) >> 8, per_ = nn_ * (K_ >> 7), ns_ = nm_ * per_; \
                if (r_ < ns_) { const int mat_ = r_ / per_, rem_ = r_ % per_, kb_ = rem_ / nn_, nb_ = rem_ % nn_; \
                    (out).N = ne_; (out).ld = N_; (out).Kd = K_; (out).n0 = nb0_ + nb_ * 256; (out).mode = TRT[j_][4]; (out).roff = TRT[j_][5]; \
                    (out).src = A.in[TRT[j_][0]] + (size_t)mat_ * ((size_t)K_ * N_) + (size_t)kb_ * 128 * N_ + nb0_ + nb_ * 256; \
                    (out).fmt = TRT[j_][7]; { const int es_ = TRT[j_][7] ? 1 : 2; (out).dst = ws + TRO[j_] + ((size_t)mat_ * ((size_t)TRT[j_][6] * K_) + kb_ * 128) * es_; } found = true; break; } \
                r_ -= ns_; } } while (0)
#define TR_LOAD(V, SL) do { _Pragma("unroll") for (int j = 0; j < 16; ++j) { const int k = 8 * j + lk; \
            V[j] = ((SL).n0 + 4 * lc < (SL).N) ? *(const f32x4*)((SL).src + (size_t)k * (SL).ld + 4 * lc) : (f32x4){0.f, 0.f, 0.f, 0.f}; } } while (0)
#define TR_STEP(V, SC, haveC) do { if (haveC) { \
            _Pragma("unroll") for (int j = 0; j < 16; ++j) { const int k = 8 * j + lk; u32x2 w; w.x = cvtpk(V[j].x, V[j].y); w.y = cvtpk(V[j].z, V[j].w); \
                *(LAS u32x2*)(lds + k * 544 + ((((lc >> 2) ^ (((k >> 3) & 1) << 2))) << 5) + 8 * (lc & 3)) = w; } \
            if (tid == 0) *wql = (int)atomicAdd(wqh, 1u); \
            __syncthreads(); \
            TrSlab Sn_; bool hn_; { const int it_ = *wql; TR_FIND(it_, Sn_, hn_); } \
            if (hn_) TR_LOAD(V, Sn_); \
            _Pragma("unroll") for (int nbk = 0; nbk < 2; ++nbk) { const int nl0 = (2 * wave + nbk) * 16; const int n = (SC).n0 + nl0 + li; \
                const int dr_ = tr_drow((SC).mode, (SC).roff, n < (SC).N ? n : 0); const bool ok = (n < (SC).N) && dr_ >= 0; \
                unsigned char* drow = (SC).dst + (size_t)(dr_ < 0 ? 0 : dr_) * (SC).Kd * ((SC).fmt ? 1 : 2); \
                _Pragma("unroll") for (int kb = 0; kb < 128; kb += 32) { \
                    const int r0 = kb + 8 * g4 + lq, r1 = r0 + 4; \
                    const int a0 = r0 * 544 + ((((nl0 >> 4) ^ (((r0 >> 3) & 1) << 2))) << 5) + 8 * lp, a1 = r1 * 544 + ((((nl0 >> 4) ^ (((r1 >> 3) & 1) << 2))) << 5) + 8 * lp; \
                    u32x2 x0, x1; \
                    asm volatile("ds_read_b64_tr_b16 %0, %1" : "=&v"(x0) : "v"((int)(uintptr_t)lds + a0) : "memory"); \
                    asm volatile("ds_read_b64_tr_b16 %0, %1" : "=&v"(x1) : "v"((int)(uintptr_t)lds + a1) : "memory"); \
                    asm volatile("s_waitcnt lgkmcnt(0)" ::: "memory"); \
                    if (ok) { if ((SC).fmt == 0) *(u32x4*)(drow + (kb + 8 * g4) * 2) = (u32x4){x0.x, x0.y, x1.x, x1.y}; \
                        else { const float sc_ = (float)(SC).fmt; *(u32x2*)(drow + kb + 8 * g4) = pack8_fp8((f32x4){bflo(x0.x) * sc_, bfhi(x0.x) * sc_, bflo(x0.y) * sc_, bfhi(x0.y) * sc_}, (f32x4){bflo(x1.x) * sc_, bfhi(x1.x) * sc_, bflo(x1.y) * sc_, bfhi(x1.y) * sc_}); } } \
                } } \
            __syncthreads(); \
            SC = Sn_; haveC = hn_; } } while (0)
        f32x4 v2[16]; TrSlab S2; bool have2 = false;
        TR_FIND(it, S, have);
        if (have) TR_LOAD(v, S);
        if (tid == 0) *wql = (int)atomicAdd(wqh, 1u);
        __syncthreads(); { const int it2 = *wql; TR_FIND(it2, S2, have2); }
        if (have2) TR_LOAD(v2, S2);
        __syncthreads();
        while (have || have2) { TR_STEP(v, S, have); TR_STEP(v2, S2, have2); }
#undef TR_STEP
#undef TR_LOAD
#undef TR_FIND
    }
    {
        f32x2* cs = (f32x2*)(ws + WS_CS); const int* pos = (const int*)A.in[I_POS];
        for (int idx = (vcu * NTHREADS + tid); idx < NT * 32; idx += G * NTHREADS) {
            const int t = idx >> 5, i = idx & 31;
            const float ang = (float)pos[t] * inv_freq_tab[i];
            const double ad = (double)ang; const double kk = __builtin_rint(ad * 0.15915494309189533577); const double r = ad - kk * 6.283185307179586476925;
            float c, s; cossin_d(r, c, s); cs[idx] = (f32x2){c, s};
        }
    }
}

struct Row { float v[4][8]; };
__device__ __forceinline__ void row_load_f32(Row& r, const float* p, int lane) {
#pragma unroll
    for (int j = 0; j < 4; ++j) { const f32x4 a = *(const f32x4*)(p + 512 * j + 8 * lane), b = *(const f32x4*)(p + 512 * j + 8 * lane + 4);
        r.v[j][0] = a.x; r.v[j][1] = a.y; r.v[j][2] = a.z; r.v[j][3] = a.w; r.v[j][4] = b.x; r.v[j][5] = b.y; r.v[j][6] = b.z; r.v[j][7] = b.w; }
}
__device__ __forceinline__ void row_store_f32(const Row& r, float* p, int lane) {
#pragma unroll
    for (int j = 0; j < 4; ++j) { *(f32x4*)(p + 512 * j + 8 * lane) = (f32x4){r.v[j][0], r.v[j][1], r.v[j][2], r.v[j][3]}; *(f32x4*)(p + 512 * j + 8 * lane + 4) = (f32x4){r.v[j][4], r.v[j][5], r.v[j][6], r.v[j][7]}; }
}
__device__ __forceinline__ void row_store_bf16(const Row& r, bf16* p, int lane) {
#pragma unroll
    for (int j = 0; j < 4; ++j) { u32x4 o; o.x = cvtpk(r.v[j][0], r.v[j][1]); o.y = cvtpk(r.v[j][2], r.v[j][3]); o.z = cvtpk(r.v[j][4], r.v[j][5]); o.w = cvtpk(r.v[j][6], r.v[j][7]); *(u32x4*)(p + 512 * j + 8 * lane) = o; }
}
__device__ __forceinline__ float row_rstd(const Row& r) {
    float s = 0.f;
#pragma unroll
    for (int j = 0; j < 4; ++j)
#pragma unroll
        for (int q = 0; q < 8; ++q) s += r.v[j][q] * r.v[j][q];
    return rsqrtf(wave_sum(s) * (1.0f / DM) + EPS);
}
struct ModPtr { const float* acc; };
__device__ __forceinline__ ModPtr mod_ptr(CArgs& A, int l, int b, int which) {
    ModPtr m; m.acc = (const float*)(A.ws + WS_CTL) + CW_MOD + ((size_t)l * NB + b) * (NMOD * DM) + which * DM; return m;
}
__device__ __forceinline__ void row_norm_mod_store(const Row& x, const float* g, ModPtr sh, ModPtr sc, bf16* hrow, int lane, unsigned char* h8row = nullptr) {
    const float rstd = row_rstd(x);
    Row o;
#pragma unroll
    for (int j = 0; j < 4; ++j) { const int c0 = 512 * j + 8 * lane;
#pragma unroll
        for (int q4 = 0; q4 < 2; ++q4) { const int c = c0 + 4 * q4;
            const f32x4 gv = *(const f32x4*)(g + c), sa = *(const f32x4*)(sh.acc + c), ca = *(const f32x4*)(sc.acc + c);
#pragma unroll
            for (int q = 0; q < 4; ++q) o.v[j][4 * q4 + q] = (x.v[j][4 * q4 + q] * rstd * gv[q]) * (1.0f + ca[q]) + sa[q]; }
        asm volatile("" ::: "memory"); }
    if (hrow) row_store_bf16(o, hrow, lane);
    if (h8row) {
#pragma unroll
        for (int j = 0; j < 4; ++j) *(u32x2*)(h8row + 512 * j + 8 * lane) = pack8_fp8((f32x4){o.v[j][0], o.v[j][1], o.v[j][2], o.v[j][3]}, (f32x4){o.v[j][4], o.v[j][5], o.v[j][6], o.v[j][7]}); }
}
__device__ __forceinline__ void norm_mod_phase(CArgs& A, const float* xin, const float* g, int l, int wsh, int wsc, int vcu, int G) {
    int tid = threadIdx.x; asm volatile("" : "+v"(tid));
    const int lane = tid & 63, wave = __builtin_amdgcn_readfirstlane(tid >> 6);
    bf16* H = (bf16*)(A.ws + WS_H);
    for (int t = vcu * NWAVES + wave; t < NT; t += G * NWAVES) {
        const int b = t / SEQ; Row x; row_load_f32(x, xin + (size_t)t * DM, lane);
        row_norm_mod_store(x, g, mod_ptr(A, l, b, wsh), mod_ptr(A, l, b, wsc), H + (size_t)t * DM, lane, A.ws + WS_H8 + (size_t)t * DM);
    }
}
__device__ __forceinline__ void postproj_phase(CArgs& A, int l, int vcu, int G) {
    int tid = threadIdx.x; asm volatile("" : "+v"(tid));
    const int lane = tid & 63, wave = __builtin_amdgcn_readfirstlane(tid >> 6);
    const bf16* P = (const bf16*)(A.ws + WS_PROJ);
    bf16* CQN = (bf16*)(A.ws + WS_CQN); bf16* CKVN = (bf16*)(A.ws + WS_CKVN); bf16* CZ = (bf16*)(A.ws + WS_CZ); unsigned char* Kb = A.ws + WS_K;
    const f32x2* cs = (const f32x2*)(A.ws + WS_CS);
    const float* gq = A.in[I_GQ] + l * QL; const float* gkv = A.in[I_GKV] + l * KVL; const float* cw = A.in[I_CONVW] + (size_t)l * 3 * CW;
    for (int t = vcu * NWAVES + wave; t < NT; t += G * NWAVES) {
        const int b = t / SEQ, s = t % SEQ; const bf16* pr = P + (size_t)t * NINP;
        {
            const u32x4 w = *(const u32x4*)(pr + PC_CQ + 8 * lane); float v[8] = {bflo(w.x), bfhi(w.x), bflo(w.y), bfhi(w.y), bflo(w.z), bfhi(w.z), bflo(w.w), bfhi(w.w)};
            float ss = 0.f;
#pragma unroll
            for (int q = 0; q < 8; ++q) ss += v[q] * v[q];
            const float rstd = rsqrtf(wave_sum(ss) * (1.0f / QL) + EPS);
            const f32x4 g0 = *(const f32x4*)(gq + 8 * lane), g1 = *(const f32x4*)(gq + 8 * lane + 4);
            u32x4 o; o.x = cvtpk(v[0] * rstd * g0.x, v[1] * rstd * g0.y); o.y = cvtpk(v[2] * rstd * g0.z, v[3] * rstd * g0.w); o.z = cvtpk(v[4] * rstd * g1.x, v[5] * rstd * g1.y); o.w = cvtpk(v[6] * rstd * g1.z, v[7] * rstd * g1.w);
            *(u32x2*)((unsigned char*)CQN + (size_t)t * QL + 8 * lane) = pack8_fp8((f32x4){v[0] * rstd * g0.x, v[1] * rstd * g0.y, v[2] * rstd * g0.z, v[3] * rstd * g0.w}, (f32x4){v[4] * rstd * g1.x, v[5] * rstd * g1.y, v[6] * rstd * g1.z, v[7] * rstd * g1.w});
        }
        {
            const u32x2 w = *(const u32x2*)(pr + PC_CKV + 4 * lane); float v[4] = {bflo(w.x), bfhi(w.x), bflo(w.y), bfhi(w.y)};
            const float rstd = rsqrtf(wave_sum(v[0] * v[0] + v[1] * v[1] + v[2] * v[2] + v[3] * v[3]) * (1.0f / KVL) + EPS);
            const f32x4 g0 = *(const f32x4*)(gkv + 4 * lane);
            u32x2 o; o.x = cvtpk(v[0] * rstd * g0.x, v[1] * rstd * g0.y); o.y = cvtpk(v[2] * rstd * g0.z, v[3] * rstd * g0.w);
            *(u32x2*)(CKVN + (size_t)t * KVL + 4 * lane) = o;
        }
        {
            const float v = __uint_as_float((unsigned)pr[PC_KPE + lane] << 16); const float o = __shfl_xor(v, 1);
            const f32x2 c = cs[t * 32 + (lane >> 1)];
            const float r = ((lane & 1) ? (v * c.x + o * c.y) : (v * c.x - o * c.y)) * 0.25f;
            const unsigned char rb = (unsigned char)(__builtin_amdgcn_cvt_pk_fp8_f32(r, r, 0, false) & 0xff);
            unsigned char* kd = Kb + ((size_t)(b * NH) * SEQ + s) * DQK + DNOPE + lane;
#pragma unroll
            for (int h = 0; h < NH; ++h) kd[(size_t)h * SEQ * DQK] = rb;
        }
        {
            const int c0 = 16 * lane;
            float z[3][16];
#pragma unroll
            for (int d = 0; d < 3; ++d) {
                const int ss = s + d - 1; const bool ok = (ss >= 0 && ss < SEQ);
                const bf16* p2 = pr + (ptrdiff_t)(d - 1) * NINP;
                u32x4 gc0 = {0, 0, 0, 0}, gc1 = gc0, u0 = gc0, u1 = gc0;
                if (ok) { gc0 = *(const u32x4*)(p2 + PC_GC + c0); gc1 = *(const u32x4*)(p2 + PC_GC + c0 + 8); u0 = *(const u32x4*)(p2 + PC_U + c0); u1 = *(const u32x4*)(p2 + PC_U + c0 + 8); }
                const unsigned gw_[8] = {gc0.x, gc0.y, gc0.z, gc0.w, gc1.x, gc1.y, gc1.z, gc1.w}, uw_[8] = {u0.x, u0.y, u0.z, u0.w, u1.x, u1.y, u1.z, u1.w};
#pragma unroll
                for (int q = 0; q < 8; ++q) { z[d][2 * q] = bflo(gw_[q]) * bflo(uw_[q]); z[d][2 * q + 1] = bfhi(gw_[q]) * bfhi(uw_[q]); }
            }
            const u32x4 gb0 = *(const u32x4*)(pr + PC_GB + c0), gb1 = *(const u32x4*)(pr + PC_GB + c0 + 8);
            const unsigned gbw[8] = {gb0.x, gb0.y, gb0.z, gb0.w, gb1.x, gb1.y, gb1.z, gb1.w};
            float o[16];
#pragma unroll
            for (int q4 = 0; q4 < 4; ++q4) { const f32x4 w0 = *(const f32x4*)(cw + c0 + 4 * q4), w1 = *(const f32x4*)(cw + CW + c0 + 4 * q4), w2 = *(const f32x4*)(cw + 2 * CW + c0 + 4 * q4);
#pragma unroll
                for (int q = 0; q < 4; ++q) { const int i = 4 * q4 + q; const float gbv = (i & 1) ? bfhi(gbw[i >> 1]) : bflo(gbw[i >> 1]); o[i] = gbv * (w0[q] * z[0][i] + w1[q] * z[1][i] + w2[q] * z[2][i]); } }
            u32x4 o0, o1; o0.x = cvtpk(o[0], o[1]); o0.y = cvtpk(o[2], o[3]); o0.z = cvtpk(o[4], o[5]); o0.w = cvtpk(o[6], o[7]); o1.x = cvtpk(o[8], o[9]); o1.y = cvtpk(o[10], o[11]); o1.z = cvtpk(o[12], o[13]); o1.w = cvtpk(o[14], o[15]);
            *(u32x4*)(CZ + (size_t)t * CW + c0) = o0; *(u32x4*)(CZ + (size_t)t * CW + c0 + 8) = o1;
        }
    }
}
__device__ __forceinline__ void nmr_phase(CArgs& A, const float* xin, int l, int vcu, LAS unsigned char* lds) {
    int tid = threadIdx.x; asm volatile("" : "+v"(tid));
    const int lane = tid & 63, wave = __builtin_amdgcn_readfirstlane(tid >> 6);
    bf16* H = (bf16*)(A.ws + WS_H); int* LIST = (int*)(A.ws + WS_LIST);
    unsigned* ASG = (unsigned*)(A.ws + WS_ASG); float* ASGW = (float*)(A.ws + WS_ASG + 512 * 1024);
    unsigned* cnt = (unsigned*)(A.ws + WS_CTL) + CW_CNT + l * 64;
    const int t0 = vcu * 32;
    {
        const float* g = A.in[I_GFFN] + (size_t)l * DM;
        for (int r = 0; r < 4; ++r) { const int t = t0 + wave * 4 + r; const int b = t / SEQ; Row x; row_load_f32(x, xin + (size_t)t * DM, lane);
            row_norm_mod_store(x, g, mod_ptr(A, l, b, 3), mod_ptr(A, l, b, 4), H + (size_t)t * DM, lane, A.ws + WS_H8 + (size_t)t * DM); }
    }
    asm volatile("s_waitcnt vmcnt(0)" ::: "memory"); __syncthreads();
    {
        const int r32 = lane & 31, hi = lane >> 5, k0 = wave * 256 + 8 * hi;
        const bf16* WR = (const bf16*)(A.ws + WS_WSR) + ((size_t)l * WSR_ROWS + 1024) * DM;
        const bf16* hp = H + (size_t)(t0 + r32) * DM + k0; const bf16* w0 = WR + (size_t)r32 * DM + k0; const bf16* w1 = w0 + (size_t)32 * DM;
        f32x16 acc0 = {}, acc1 = {};
#pragma unroll 4
        for (int s = 0; s < 16; ++s) { const bf16x8 hb = *(const bf16x8*)(hp + 16 * s), a0 = *(const bf16x8*)(w0 + 16 * s), a1 = *(const bf16x8*)(w1 + 16 * s);
            acc0 = __builtin_amdgcn_mfma_f32_32x32x16_bf16(a0, hb, acc0, 0, 0, 0); acc1 = __builtin_amdgcn_mfma_f32_32x32x16_bf16(a1, hb, acc1, 0, 0, 0); }
        LAS float* part = (LAS float*)lds + (size_t)(wave * 32 + r32) * 64;
#pragma unroll
        for (int r = 0; r < 16; ++r) { const int e = (r & 3) + 8 * (r >> 2) + 4 * hi; part[e] = acc0[r]; part[32 + e] = acc1[r]; }
    }
    __syncthreads();
    const float br = A.in[I_BR][l * NE + lane];
    for (int r = 0; r < 4; ++r) {
        const int tl = wave * 4 + r, t = t0 + tl;
        float lg = 0.f;
#pragma unroll
        for (int w8 = 0; w8 < 8; ++w8) lg += ((LAS float*)lds)[(size_t)(w8 * 32 + tl) * 64 + lane];
        const float score = 1.0f / (1.0f + expf(-lg)); const float biased = score + br;
        float m1 = biased; int i1 = lane;
#pragma unroll
        for (int o = 1; o < 8; o <<= 1) { const float ov = __shfl_xor(m1, o); const int oi = __shfl_xor(i1, o); if (ov > m1 || (ov == m1 && oi < i1)) { m1 = ov; i1 = oi; } }
        float m2 = (lane == i1) ? -INFINITY : biased;
#pragma unroll
        for (int o = 1; o < 8; o <<= 1) m2 = fmaxf(m2, __shfl_xor(m2, o));
        const float gs = m1 + m2; const int grp = lane >> 3;
        int grank = 0;
#pragma unroll
        for (int g2 = 0; g2 < 8; ++g2) { const float og = readlane_f(gs, g2 * 8); grank += (og > gs || (og == gs && g2 < grp)) ? 1 : 0; }
        const bool allowed = grank < 4;
        const float mv = allowed ? biased : -INFINITY;
        int rank = 0;
#pragma unroll
        for (int e2 = 0; e2 < 64; ++e2) { const float ov = readlane_f(mv, e2); rank += (ov > mv || (ov == mv && e2 < lane)) ? 1 : 0; }
        const bool sel = allowed && rank < TOPK;
        const float ssum = wave_sum(sel ? score : 0.f);
        if (sel) {
            const unsigned slot = atomicAdd(cnt + lane, 1u);
            LIST[lane * NT + slot] = t; ASG[(size_t)t * 8 + rank] = ((unsigned)lane << 16) | slot; ASGW[(size_t)t * 8 + rank] = score / ssum * 2.5f;
        }
    }
    __syncthreads();
}

template <int K_, class Epi, class Ord = pg::GridOrder, bool FP8_ = false> struct DenseP {
    static constexpr int K = K_, LDA = K_, LDB = K_, ES = FP8_ ? 1 : 2; static constexpr bool PERM = Epi::PERM, GATHER = false, HALF = false, FP8 = FP8_; static constexpr int BMODE = pg::bmode_of<Epi>::value;
    const char* A; const char* Bt; Ord ord; Epi e;
    __device__ __forceinline__ bool next(int i, pg::Unit& u) const { u.aux = 0; u.aux2 = 0; u.half = 0; return ord.get(i, u.pm, u.pn); }
    __device__ __forceinline__ const char* a_base(const pg::Unit& u) const { return A + (size_t)u.pm * 256 * K * ES; }
    __device__ __forceinline__ const char* b_base(const pg::Unit& u) const { return Bt + (size_t)u.pn * 256 * K * ES; }
    __device__ __forceinline__ void a_offsets(const pg::Unit&, unsigned (&)[2][2]) const {}
    __device__ __forceinline__ void epi(const pg::Acc& acc, const pg::Unit& u, int wr, int wc, int fr, int fq) const { e(acc, u, wr, wc, fr, fq); }
};
template <class Epi, int K_ = DM, class Ord = pg::GridOrder> struct WinP {
    static constexpr int K = K_, LDA = K_, LDB = K_; static constexpr bool PERM = Epi::PERM, GATHER = true, HALF = false, FP8 = true;
    const char* A; const char* Bt; Ord ord; Epi e;
    __device__ __forceinline__ bool next(int i, pg::Unit& u) const { u.aux = 0; u.aux2 = 0; u.half = 0; return ord.get(i, u.pm, u.pn); }
    __device__ __forceinline__ const char* a_base(const pg::Unit&) const { return A; }
    __device__ __forceinline__ const char* b_base(const pg::Unit& u) const { return Bt + (size_t)u.pn * 256 * K; }
    __device__ __forceinline__ void a_offsets(const pg::Unit& u, unsigned (&off)[2][2]) const {
        int R[2], C[2]; { const int t_ = otid(); pg::stage_rc(t_ * 16, R[0], C[0]); pg::stage_rc(t_ * 16 + 8192, R[1], C[1]); }
#pragma unroll
        for (int h = 0; h < 2; ++h)
#pragma unroll
            for (int i = 0; i < 2; ++i) off[h][i] = (unsigned)((u.pm * 256 + R[i] + 128 * h) * K + C[i] * 2);
    }
    __device__ __forceinline__ void epi(const pg::Acc& acc, const pg::Unit& u, int wr, int wc, int fr, int fq) const { e(acc, u, wr, wc, fr, fq); }
};
#define EPI_ROWS_BEGIN _Pragma("unroll") for (int ai = 0; ai < 2; ++ai) _Pragma("unroll") for (int m = 0; m < 4; ++m) { const int rl = ai * 128 + wr * 64 + m * 16 + fr; const int row = u.pm * 256 + rl; (void)row;
#define EPI_ROWS_END }
__device__ __forceinline__ u32x4 pack8(const f32x4 a, const f32x4 b) { u32x4 w; w.x = cvtpk(a[0], a[1]); w.y = cvtpk(a[2], a[3]); w.z = cvtpk(b[0], b[1]); w.w = cvtpk(b[2], b[3]); return w; }
__device__ __forceinline__ void unpack8(const u32x4 w, f32x4& a, f32x4& b) { a = (f32x4){bflo(w.x), bfhi(w.x), bflo(w.y), bfhi(w.y)}; b = (f32x4){bflo(w.z), bfhi(w.z), bflo(w.w), bfhi(w.w)}; }
struct EpiProj { static constexpr bool PERM = true; bf16* P; float isc; int pn0;
    __device__ __forceinline__ void operator()(const pg::Acc& acc, const pg::Unit& u, int wr, int wc, int fr, int fq) const {
        const int pn = u.pn + pn0; const bool sg = pn >= PC_LA / 256;
        EPI_ROWS_BEGIN
#pragma unroll
            for (int bj = 0; bj < 2; ++bj) { f32x4 v0 = acc[ai][bj][m][0] * isc, v1 = acc[ai][bj][m][1] * isc;
                if (sg) {
#pragma unroll
                    for (int q = 0; q < 4; ++q) { v0[q] = sigmoidf_(v0[q]); v1[q] = sigmoidf_(v1[q]); } }
                *(u32x4*)(P + (size_t)row * NINP + pn * 256 + bj * 128 + wc * 32 + 8 * fq) = pack8(v0, v1); }
        EPI_ROWS_END
    } };
#define EPI_G(g) const int ai = (g) >> 2, m = (g) & 3; const int rl = ai * 128 + wr * 64 + m * 16 + fr; const int row = u.pm * 256 + rl; (void)row; (void)ai; (void)m;
template <class E> __device__ __forceinline__ void epi_pipelined(const E& e, const pg::Acc& acc, const pg::Unit& u, int wr, int wc, int fr, int fq) {
    typename E::Regs r0, r1;
    e.load(r0, u, 0, wr, wc, fr, fq);
#pragma unroll
    for (int g = 0; g < 8; g += 2) {
        e.load(r1, u, g + 1, wr, wc, fr, fq);
        asm volatile("" ::: "memory");
        e.finish(r0, acc, u, g, wr, wc, fr, fq);
        asm volatile("" ::: "memory");
        if (g + 2 < 8) e.load(r0, u, g + 2, wr, wc, fr, fq);
        asm volatile("" ::: "memory");
        e.finish(r1, acc, u, g + 1, wr, wc, fr, fq);
        asm volatile("" ::: "memory");
    }
}
constexpr float QSCALE = 0.07216878364870322f * 1.4426950408889634f * 4.0f, KSCALE = 0.25f;
struct EpiQ { static constexpr bool PERM = true; unsigned char* Q; const f32x2* cs;
    struct Regs { f32x2 c[2][4]; };
    __device__ __forceinline__ void load(Regs& r, const pg::Unit& u, int g, int wr, int wc, int fr, int fq) const {
        EPI_G(g)
#pragma unroll
        for (int bj = 0; bj < 2; ++bj) { const int col = u.pn * 256 + bj * 128 + wc * 32 + 8 * fq; const int d = col % DQK;
            if (d >= DNOPE) { const f32x2* c = cs + (size_t)row * 32 + ((d - DNOPE) >> 1); r.c[bj][0] = c[0]; r.c[bj][1] = c[1]; r.c[bj][2] = c[2]; r.c[bj][3] = c[3]; } }
    }
    __device__ __forceinline__ void finish(const Regs& r, const pg::Acc& acc, const pg::Unit& u, int g, int wr, int wc, int fr, int fq) const {
        constexpr float SC = (1.0f / W2_SCALE) * QSCALE;
        EPI_G(g)
        const int b = row / SEQ, s = row % SEQ;
#pragma unroll
        for (int bj = 0; bj < 2; ++bj) { const int col = u.pn * 256 + bj * 128 + wc * 32 + 8 * fq; const int head = col / DQK, d = col % DQK;
            f32x4 v0 = acc[ai][bj][m][0] * SC, v1 = acc[ai][bj][m][1] * SC;
            if (d >= DNOPE) { const f32x2 c0 = r.c[bj][0], c1 = r.c[bj][1], c2 = r.c[bj][2], c3 = r.c[bj][3];
                const f32x4 r0 = {v0[0] * c0.x - v0[1] * c0.y, v0[1] * c0.x + v0[0] * c0.y, v0[2] * c1.x - v0[3] * c1.y, v0[3] * c1.x + v0[2] * c1.y};
                const f32x4 r1 = {v1[0] * c2.x - v1[1] * c2.y, v1[1] * c2.x + v1[0] * c2.y, v1[2] * c3.x - v1[3] * c3.y, v1[3] * c3.x + v1[2] * c3.y};
                v0 = r0; v1 = r1; }
            *(u32x2*)(Q + ((size_t)(b * NH + head) * SEQ + s) * DQK + d) = pack8_fp8(v0, v1); }
    }
    __device__ __forceinline__ void operator()(const pg::Acc& acc, const pg::Unit& u, int wr, int wc, int fr, int fq) const { epi_pipelined(*this, acc, u, wr, wc, fr, fq); }
};
struct EpiK { static constexpr bool PERM = true; static constexpr int BMODE = 1; unsigned char* Kb;
    __device__ __forceinline__ void operator()(const pg::Acc& acc, const pg::Unit& u, int wr, int wc, int fr, int fq) const {
        EPI_ROWS_BEGIN
            const int b = row / SEQ, s = row % SEQ;
            const u32x2 lo = pack8_fp8(acc[ai][0][m][0] * KSCALE, acc[ai][0][m][1] * KSCALE), hi2 = pack8_fp8(acc[ai][1][m][0] * KSCALE, acc[ai][1][m][1] * KSCALE);
            *(u32x4*)(Kb + ((size_t)(b * NH + u.pn * 2 + (wc >> 1)) * SEQ + s) * DQK + (wc & 1) * 64 + 16 * fq) = (u32x4){lo.x, lo.y, hi2.x, hi2.y};
        EPI_ROWS_END
    } };
struct EpiVt { static constexpr bool PERM = true; static constexpr int BMODE = 2; unsigned char* Vt;
    __device__ __forceinline__ void operator()(const pg::Acc& acc, const pg::Unit& u, int wr, int wc, int fr, int fq) const {
        const int t0 = u.pn * 256 + 64 * wc; const int b = t0 / SEQ, s0 = t0 % SEQ; const int pos = s0 + 32 * (fq & 1) + 16 * (fq >> 1);
        EPI_ROWS_BEGIN
            const int h = row >> 7, d = row & 127;
            u32x4 w4;
#pragma unroll
            for (int c = 0; c < 4; ++c) { const int bj = c >> 1, n = c & 1; int w = 0;
                w = __builtin_amdgcn_cvt_pk_fp8_f32(acc[ai][bj][m][n][0], acc[ai][bj][m][n][1], w, false); w = __builtin_amdgcn_cvt_pk_fp8_f32(acc[ai][bj][m][n][2], acc[ai][bj][m][n][3], w, true); w4[c] = (unsigned)w; }
            *(u32x4*)(Vt + ((size_t)((b * NH + h) * DV + d)) * SEQ + pos) = w4;
        EPI_ROWS_END
    } };
struct EpiConv { static constexpr bool PERM = true; const bf16* P; bf16* M1;
    struct Regs { u32x4 p[2]; };
    __device__ __forceinline__ void load(Regs& r, const pg::Unit& u, int g, int wr, int wc, int fr, int fq) const {
        EPI_G(g)
#pragma unroll
        for (int bj = 0; bj < 2; ++bj) r.p[bj] = *(const u32x4*)(P + (size_t)row * NINP + PC_LC + u.pn * 256 + bj * 128 + wc * 32 + 8 * fq);
    }
    __device__ __forceinline__ void finish(const Regs& r, const pg::Acc& acc, const pg::Unit& u, int g, int wr, int wc, int fr, int fq) const {
        EPI_G(g)
#pragma unroll
        for (int bj = 0; bj < 2; ++bj) { const int col = u.pn * 256 + bj * 128 + wc * 32 + 8 * fq; f32x4 g0, g1; unpack8(r.p[bj], g0, g1);
            *(u32x4*)(M1 + (size_t)row * DM + col) = pack8(acc[ai][bj][m][0] * g0, acc[ai][bj][m][1] * g1); }
    }
    __device__ __forceinline__ void operator()(const pg::Acc& acc, const pg::Unit& u, int wr, int wc, int fr, int fq) const { epi_pipelined(*this, acc, u, wr, wc, fr, fq); }
};
struct EpiWo { static constexpr bool PERM = true; const bf16* P; const bf16* M1; bf16* MIX; unsigned char* MIX8; float isc;
    struct Regs { u32x4 p[2], q[2]; };
    __device__ __forceinline__ void load(Regs& r, const pg::Unit& u, int g, int wr, int wc, int fr, int fq) const {
        EPI_G(g)
#pragma unroll
        for (int bj = 0; bj < 2; ++bj) { const int col = u.pn * 256 + bj * 128 + wc * 32 + 8 * fq; r.p[bj] = *(const u32x4*)(P + (size_t)row * NINP + PC_LA + col); r.q[bj] = *(const u32x4*)(M1 + (size_t)row * DM + col); }
    }
    __device__ __forceinline__ void finish(const Regs& r, const pg::Acc& acc, const pg::Unit& u, int g, int wr, int wc, int fr, int fq) const {
        EPI_G(g)
#pragma unroll
        for (int bj = 0; bj < 2; ++bj) { const int col = u.pn * 256 + bj * 128 + wc * 32 + 8 * fq; f32x4 g0, g1, a0, a1; unpack8(r.p[bj], g0, g1); unpack8(r.q[bj], a0, a1);
            const f32x4 m0 = acc[ai][bj][m][0] * isc * g0 + a0, m1v = acc[ai][bj][m][1] * isc * g1 + a1;
            if (FP8_WOUT) *(u32x2*)(MIX8 + (size_t)row * DM + col) = pack8_fp8(m0, m1v); else *(u32x4*)(MIX + (size_t)row * DM + col) = pack8(m0, m1v); }
    }
    __device__ __forceinline__ void operator()(const pg::Acc& acc, const pg::Unit& u, int wr, int wc, int fr, int fq) const { epi_pipelined(*this, acc, u, wr, wc, fr, fq); }
};
struct EpiWout { static constexpr bool PERM = false; const float* xin; float* xout; const float* gacc; float isc;
    struct Regs { f32x4 x[2][2]; };
    __device__ __forceinline__ void load(Regs& r, const pg::Unit& u, int g, int wr, int wc, int fr, int fq) const {
        const int ai = g >> 2, m = g & 3; const size_t rowA = (size_t)u.pm * 256 + ai * 128 + wr * 64 + m * 16 + (fr & 7);
#pragma unroll
        for (int bj = 0; bj < 2; ++bj) { const int col = u.pn * 256 + bj * 128 + wc * 32 + 16 * (fr >> 3) + 4 * fq;
            r.x[bj][0] = *(const f32x4*)(xin + rowA * DM + col); r.x[bj][1] = *(const f32x4*)(xin + (rowA + 8) * DM + col); }
    }
    __device__ __forceinline__ void finish(const Regs& r, const pg::Acc& acc, const pg::Unit& u, int g, int wr, int wc, int fr, int fq) const {
        const int ai = g >> 2, m = g & 3; const size_t rowA = (size_t)u.pm * 256 + ai * 128 + wr * 64 + m * 16 + (fr & 7);
        const int b = (u.pm * 256) / SEQ; const bool lo = fr < 8;
#pragma unroll
        for (int bj = 0; bj < 2; ++bj) { const int col = u.pn * 256 + bj * 128 + wc * 32 + 16 * (fr >> 3) + 4 * fq;
            const f32x4 a0 = acc[ai][bj][m][0], a1 = acc[ai][bj][m][1];
            f32x4 rc;
#pragma unroll
            for (int q = 0; q < 4; ++q) rc[q] = dpp_f<0x128>(lo ? a1[q] : a0[q]);
            f32x4 vA, vB;
#pragma unroll
            for (int q = 0; q < 4; ++q) { vA[q] = lo ? a0[q] : rc[q]; vB[q] = lo ? rc[q] : a1[q]; }
            const f32x4 gv = *(const f32x4*)(gacc + (size_t)b * (NMOD * DM) + col);
            *(f32x4*)(xout + rowA * DM + col) = r.x[bj][0] + gv * (vA * isc); *(f32x4*)(xout + (rowA + 8) * DM + col) = r.x[bj][1] + gv * (vB * isc); }
    }
    __device__ __forceinline__ void operator()(const pg::Acc& acc, const pg::Unit& u, int wr, int wc, int fr, int fq) const { epi_pipelined(*this, acc, u, wr, wc, fr, fq); }
};
struct MoeTab { LAS int* cnt; LAS int* ts; LAS int* ord; };
__device__ __forceinline__ int wave_incl_scan(int v, int lane) {
#pragma unroll
    for (int o = 1; o < 64; o <<= 1) { const int u = __shfl_up(v, o); v += (lane >= o) ? u : 0; }
    return v;
}
__device__ __forceinline__ MoeTab moe_tables(CArgs& A, int l, LAS unsigned char* lds, bool want_order) {
    MoeTab T; T.cnt = (LAS int*)(lds + LDS_TAB + 256); T.ts = T.cnt + 64; T.ord = (LAS int*)(lds + LDS_TAB + 1024) + 1;
    unsigned* cg = (unsigned*)(A.ws + WS_CTL) + CW_CNT + l * 64;
    const int tt = otid();
    __syncthreads();
    if (tt < 64) {
        const int e = tt; const int c = (int)__hip_atomic_load(cg + e, RLX_AGENT);
        T.cnt[e] = c;
        const int nall = (c + 255) >> 8; const int ia = wave_incl_scan(nall, e);
        T.ts[e] = ia - nall; if (e == 63) T.ts[64] = ia;
        if (want_order) {
            const int nfull = c >> 8, rem = c & 255;
            const int n1 = nfull + (rem > 128 ? 1 : 0), nh = (rem != 0 && rem <= 128) ? 1 : 0;
            const int p1 = wave_incl_scan(n1, e), ph = wave_incl_scan(nh, e);
            const int tot1 = __builtin_amdgcn_readlane(p1, 63), toth = __builtin_amdgcn_readlane(ph, 63);
            if (e < NT / 256) T.ord[e] = 64 | (e << 8);
            const int pos = NT / 256 + p1 - n1;
#pragma nounroll
            for (int m = 0; m < n1; ++m) T.ord[pos + m] = e | (m << 8);
            if (nh) T.ord[NT / 256 + tot1 + ph - 1] = e | (nfull << 8) | (1 << 16);
            if (e == 0) T.ord[-1] = NT / 256 + tot1 + toth;
        }
    }
    __syncthreads();
    return T;
}
struct Moe1P {
    static constexpr int K = DM, LDA = DM, LDB = DM; static constexpr bool PERM = true, GATHER = true, HALF = true, FP8 = true, PEEL = true;
    const char* H; const char* W; const char* WSH; const int* LIST; bf16* ACT; bf16* SACT; MoeTab T; int G, c;
    __device__ __forceinline__ bool next(int i, pg::Unit& u) const {
        const int L = i * 256 + (c & 7) * 32 + (c >> 3); const int ti = L >> 2;
        if (ti >= T.ord[-1]) return false;
        const int en = T.ord[ti]; const int e = en & 255, mt = (en >> 8) & 255;
        u.pn = L & 3; u.pm = mt; u.aux = e; u.half = en >> 16; u.aux2 = (e < 64 ? T.ts[e] + mt : mt) * 256;
        return true;
    }
    __device__ __forceinline__ const char* a_base(const pg::Unit&) const { return H; }
    __device__ __forceinline__ const char* b_base(const pg::Unit& u) const { return u.aux < 64 ? W + ((size_t)u.aux * 1024 + (size_t)u.pn * 256) * K : WSH + (size_t)u.pn * 256 * K; }
    __device__ __forceinline__ void a_offsets(const pg::Unit& u, unsigned (&off)[2][2]) const {
        int R[2], C[2]; { const int t_ = otid(); pg::stage_rc(t_ * 16, R[0], C[0]); pg::stage_rc(t_ * 16 + 8192, R[1], C[1]); }
        if (u.aux < 64) {
            const int n = T.cnt[u.aux]; const int* lp = LIST + (size_t)u.aux * NT + u.pm * 256;
#pragma unroll
            for (int h = 0; h < 2; ++h)
#pragma unroll
                for (int i = 0; i < 2; ++i) { const int r = R[i] + 128 * h; const int tok = (u.pm * 256 + r < n) ? lp[r] : 0; off[h][i] = (unsigned)(tok * K + C[i] * 2); }
        } else {
#pragma unroll
            for (int h = 0; h < 2; ++h)
#pragma unroll
                for (int i = 0; i < 2; ++i) off[h][i] = (unsigned)((u.pm * 256 + R[i] + 128 * h) * K + C[i] * 2);
        }
    }
    __device__ __forceinline__ void epi(const pg::Acc& acc, const pg::Unit& u, int wr, int wc, int fr, int fq) const {
        bf16* D = u.aux < 64 ? ACT : SACT;
        EPI_ROWS_BEGIN
            if (ai == 1 && u.half) continue;
            f32x4 v0, v1;
#pragma unroll
            for (int q = 0; q < 4; ++q) { constexpr float IS = 1.0f / W13_SCALE; v0[q] = siluf_(acc[ai][0][m][0][q] * IS) * (acc[ai][1][m][0][q] * IS); v1[q] = siluf_(acc[ai][0][m][1][q] * IS) * (acc[ai][1][m][1][q] * IS); }
            *(u32x2*)((unsigned char*)D + (size_t)(u.aux2 + rl) * DE + u.pn * 128 + wc * 32 + 8 * fq) = pack8_fp8(v0, v1);
        EPI_ROWS_END
    }
};
struct Moe2P {
    static constexpr int K = DE, LDA = DE, LDB = DE; static constexpr bool PERM = true, GATHER = false, HALF = true, FP8 = true, PEEL = true; static constexpr int BMODE = 1;
    const char* ACT; const char* SACT; const char* W; const char* WS2; bf16* OUT2; MoeTab T; int G, c;
    __device__ __forceinline__ bool next(int i, pg::Unit& u) const {
        const int L = i * 256 + (c & 7) * 32 + (c >> 3); const int ti = L >> 3;
        if (ti >= T.ord[-1]) return false;
        const int en = T.ord[ti]; const int e = en & 255, mt = (en >> 8) & 255;
        u.pn = L & 7; u.aux = e; u.half = en >> 16;
        if (e < 64) { u.pm = T.ts[e] + mt; u.aux2 = u.pm * 256; } else { u.pm = mt; u.aux2 = MAXROWS + mt * 256; }
        return true;
    }
    __device__ __forceinline__ const char* a_base(const pg::Unit& u) const { return u.aux < 64 ? ACT + (size_t)u.pm * 256 * K : SACT + (size_t)u.pm * 256 * K; }
    __device__ __forceinline__ const char* b_base(const pg::Unit& u) const { return u.aux < 64 ? W + ((size_t)u.aux * DM + (size_t)u.pn * 256) * K : WS2 + (size_t)u.pn * 256 * K; }
    __device__ __forceinline__ void a_offsets(const pg::Unit&, unsigned (&)[2][2]) const {}
    __device__ __forceinline__ void epi(const pg::Acc& acc, const pg::Unit& u, int wr, int wc, int fr, int fq) const {
        EPI_ROWS_BEGIN
            if (ai == 1 && u.half) continue;
            { const u32x2 lo = pack8_fp8(acc[ai][0][m][0] * (1.0f / W2_SCALE), acc[ai][0][m][1] * (1.0f / W2_SCALE)), hi2 = pack8_fp8(acc[ai][1][m][0] * (1.0f / W2_SCALE), acc[ai][1][m][1] * (1.0f / W2_SCALE));
              *(u32x4*)((unsigned char*)OUT2 + (size_t)(u.aux2 + rl) * DM + u.pn * 256 + wc * 64 + 16 * fq) = (u32x4){lo.x, lo.y, hi2.x, hi2.y}; }
        EPI_ROWS_END
    }
};

namespace att {
typedef int v8i __attribute__((ext_vector_type(8))); typedef int v4i __attribute__((ext_vector_type(4)));
constexpr int NW = 8, QBLK = 32, KVBLK = 64;
constexpr int SHM_V = KVBLK * DV, SHM_K = KVBLK * DQK;
constexpr int SHM_ATTN = 128 * 1024;
#ifndef ATT_SDEPTH
#define ATT_SDEPTH 1
#endif
constexpr int SDEPTH = ATT_SDEPTH;
constexpr float THR = 5.f;
#define KSWZ(row, colB) ((row) * (DQK * 2) + ((colB) ^ ((((row) >> 1) & 7) << 4)))
#define SBAR() __builtin_amdgcn_sched_barrier(0)
__device__ __forceinline__ int crow(int r, int hi) { return (r & 3) + 8 * (r >> 2) + 4 * hi; }
constexpr float THR2 = 5.f * 1.4426950408889634f;
template <bool FIRST>
__device__ __forceinline__ void partialSM(f32x16& p0, f32x16& p1, float& m_reg, f32x16& nm16, float& alpha) {
  float pmax = p0[0];
#pragma unroll
  for (int r = 1; r < 16; ++r) pmax = fmaxf(pmax, p0[r]);
#pragma unroll
  for (int r = 0; r < 16; ++r) pmax = fmaxf(pmax, p1[r]);
  { auto rr = __builtin_amdgcn_permlane32_swap(__float_as_uint(pmax), __float_as_uint(pmax), false, false);
    pmax = fmaxf(__uint_as_float(rr[0]), __uint_as_float(rr[1])); }
  if (!FIRST && __builtin_expect(__all(pmax <= THR2), 1)) { alpha = 1.f; }
  else { const float d = FIRST ? pmax : fmaxf(pmax, 0.f);
    alpha = FIRST ? 1.f : __builtin_amdgcn_exp2f(-d); m_reg += d;
    const float nm = -m_reg;
#pragma unroll
    for (int r = 0; r < 16; ++r) { p0[r] -= d; p1[r] -= d; float t = nm16[r]; asm volatile("v_mov_b32 %0, %1" : "+v"(t) : "v"(nm)); nm16[r] = t; } }
#pragma unroll
  for (int r = 0; r < 16; ++r) p0[r] = __builtin_amdgcn_exp2f(p0[r]);
}
__device__ __forceinline__ void finishSM(f32x16& p0, f32x16& p1, float alpha, float& l_reg, v8i& pa) {
#pragma unroll
  for (int r = 0; r < 16; ++r) p1[r] = __builtin_amdgcn_exp2f(p1[r]);
  float ps = 0;
#pragma unroll
  for (int r = 0; r < 16; ++r) ps += p0[r];
#pragma unroll
  for (int r = 0; r < 16; ++r) ps += p1[r];
  { auto rr = __builtin_amdgcn_permlane32_swap(__float_as_uint(ps), __float_as_uint(ps), false, false);
    ps = __uint_as_float(rr[0]) + __uint_as_float(rr[1]); }
  l_reg = l_reg * alpha + ps;
#pragma unroll
  for (int q = 0; q < 4; ++q) { int w0 = pa[q], w1 = pa[4 + q];
    w0 = __builtin_amdgcn_cvt_pk_fp8_f32(p0[4 * q], p0[4 * q + 1], w0, false); w0 = __builtin_amdgcn_cvt_pk_fp8_f32(p0[4 * q + 2], p0[4 * q + 3], w0, true);
    w1 = __builtin_amdgcn_cvt_pk_fp8_f32(p1[4 * q], p1[4 * q + 1], w1, false); w1 = __builtin_amdgcn_cvt_pk_fp8_f32(p1[4 * q + 2], p1[4 * q + 3], w1, true);
    pa[q] = w0; pa[4 + q] = w1; }
}
__device__ __forceinline__ int k8_off(int row, int c) { return row * DQK + (((c & ~3) | ((c & 3) ^ ((row >> 2) & 3))) << 4); }
__device__ __forceinline__ void qkt(f32x16& p0, f32x16& p1, const char* Ks, const v8i* qr, int r32, int hi, const f32x16& nm16) {
#pragma unroll
  for (int s = 0; s < 3; ++s) { const int c0 = 4 * s + 2 * hi;
    const v8i a0 = __builtin_shufflevector(*reinterpret_cast<const v4i*>(Ks + k8_off(r32, c0)), *reinterpret_cast<const v4i*>(Ks + k8_off(r32, c0 + 1)), 0, 1, 2, 3, 4, 5, 6, 7);
    const v8i a1 = __builtin_shufflevector(*reinterpret_cast<const v4i*>(Ks + 32 * DQK + k8_off(r32, c0)), *reinterpret_cast<const v4i*>(Ks + 32 * DQK + k8_off(r32, c0 + 1)), 0, 1, 2, 3, 4, 5, 6, 7);
    p0 = __builtin_amdgcn_mfma_scale_f32_32x32x64_f8f6f4(a0, qr[s], s == 0 ? nm16 : p0, 0, 0, 0, 0, 0, 0);
    p1 = __builtin_amdgcn_mfma_scale_f32_32x32x64_f8f6f4(a1, qr[s], s == 0 ? nm16 : p1, 0, 0, 0, 0, 0, 0); }
}
__device__ __forceinline__ void pv_d0(f32x16* o, const char* Vs, v8i pa, int r32, int hi) {
#pragma unroll
  for (int d0 = 0; d0 < 4; ++d0) { const int row = 32 * d0 + r32, x = (row >> 2) & 3;
    const v8i vb = __builtin_shufflevector(*reinterpret_cast<const v4i*>(Vs + row * 64 + (((2 * hi) ^ x) << 4)), *reinterpret_cast<const v4i*>(Vs + row * 64 + (((2 * hi + 1) ^ x) << 4)), 0, 1, 2, 3, 4, 5, 6, 7);
    o[d0] = __builtin_amdgcn_mfma_scale_f32_32x32x64_f8f6f4(pa, vb, o[d0], 0, 0, 0, 0, 0, 0); }
}
__device__ __forceinline__ void attn_unit(const unsigned char* __restrict__ CQt, const unsigned char* __restrict__ Wh, const f32x2* __restrict__ cst, const unsigned char* __restrict__ Kh, const unsigned char* __restrict__ Vh, bf16* __restrict__ Ob, char* lds) {
  int tid = threadIdx.x; asm volatile("" : "+v"(tid));
  const int wid = __builtin_amdgcn_readfirstlane(tid >> 6), lane = tid & 63, r32 = lane & 31, hi = lane >> 5;
#define VS(b) ((b) == 0 ? 0 : 24 * 1024 + (b) * SHM_V)
#define KS(b) ((b) == 0 ? 8 * 1024 : ((b) == 1 ? 20 * 1024 : 48 * 1024))
  constexpr int WIMG = 32 * 1024;
  float* wsp = (float*)(lds + 60 * 1024) + wid * 64; float* li_l = wsp; float* al_l = wsp + 32;
  float m_reg = 0.f, l_reg = 0; f32x16 o[4] = {}; v8i qr[3]; f32x16 nm16 = {};
  int koff[2], voff[2];
#pragma unroll
  for (int i = 0; i < 2; ++i) { const int m = (i * 8 + wid) * 64 + lane, row = m / 12, cp = m % 12; const int c = (cp & ~3) | ((cp & 3) ^ ((row >> 2) & 3)); koff[i] = row * DQK + c * 16; }
  { const int m = wid * 64 + lane, d = m >> 2, cp = m & 3; voff[0] = d * SEQ + ((cp ^ ((d >> 2) & 3)) << 4); voff[1] = 0; }
#define ADMA(t, b) do { __builtin_amdgcn_global_load_lds((const unsigned*)(Kh + (long)(t) * KVBLK * DQK + koff[0]), (LAS unsigned*)(LAS char*)(lds + KS(b) + wid * 1024), 16, 0, 0); \
    if (wid < 4) __builtin_amdgcn_global_load_lds((const unsigned*)(Kh + (long)(t) * KVBLK * DQK + koff[1]), (LAS unsigned*)(LAS char*)(lds + KS(b) + (8 + wid) * 1024), 16, 0, 0); \
    __builtin_amdgcn_global_load_lds((const unsigned*)(Vh + (long)(t) * KVBLK + voff[0]), (LAS unsigned*)(LAS char*)(lds + VS(b) + wid * 1024), 16, 0, 0); } while (0)
#define AWAIT(n) asm volatile("s_waitcnt vmcnt(" #n ")" ::: "memory")
#define ABAR() do { asm volatile("" ::: "memory"); __builtin_amdgcn_s_barrier(); asm volatile("" ::: "memory"); } while (0)
#define RESC(a) do { if (__any((a) < 1.f)) { if (hi == 0) al_l[r32] = (a); asm volatile("s_waitcnt lgkmcnt(0)" ::: "memory"); \
    _Pragma("unroll") for (int d = 0; d < 4; ++d) _Pragma("unroll") for (int r = 0; r < 16; ++r) o[d][r] *= al_l[crow(r, hi)]; } } while (0)
  f32x16 pA0, pA1, pB0, pB1; float alA, alB; v8i pa = {0, 0, 0, 0, 0, 0, 0, 0}; constexpr int NTL = SEQ / KVBLK;
#define ASTEP(X0, X1, alX, Y0, Y1, alY, jt, bp, bc, bn) do { \
    if ((jt) + 1 < NTL) ADMA((jt) + 1, bn); \
    SBAR(); qkt(X0, X1, lds + KS(bc), qr, r32, hi, nm16); \
    finishSM(Y0, Y1, alY, l_reg, pa); SBAR(); \
    pv_d0(o, lds + VS(bp), pa, r32, hi); partialSM<false>(X0, X1, m_reg, nm16, alX); \
    RESC(alX); \
    AWAIT(0); ABAR(); } while (0)
#define ASTEP_B(jt, bp, bc, bn) ASTEP(pB0, pB1, alB, pA0, pA1, alA, jt, bp, bc, bn)
#define ASTEP_A(jt, bp, bc, bn) ASTEP(pA0, pA1, alA, pB0, pB1, alB, jt, bp, bc, bn)
  {
#pragma unroll
    for (int i = 0; i < 12; ++i) { const int m = i * 512 + tid, row = m >> 5, cp = m & 31;
      __builtin_amdgcn_global_load_lds((const unsigned*)(Wh + (long)row * QL + ((cp ^ (row & 15)) << 4)), (LAS unsigned*)(LAS char*)(lds + WIMG + (i * 8 + wid) * 1024), 16, 0, 0); }
    ADMA(0, 0);
    const unsigned char* cq = CQt + (long)(wid * QBLK + r32) * QL + hi * 32;
    v8i cb[8];
#pragma unroll
    for (int ks = 0; ks < 8; ++ks) cb[ks] = *reinterpret_cast<const v8i*>(cq + ks * 64);
    const f32x2* csl = cst + (long)(wid * QBLK + r32) * 32 + 16 * hi;
    constexpr float QS = QSCALE / 32.0f;
    asm volatile("s_waitcnt vmcnt(0)" ::: "memory"); __builtin_amdgcn_s_barrier(); asm volatile("" ::: "memory");
    const int x15 = r32 & 15;
#pragma unroll
    for (int s3 = 0; s3 < 3; ++s3) {
      f32x16 a0 = {}, a1 = {};
      f32x2 cc[16];
      if (s3 == 2) {
#pragma unroll
        for (int r = 0; r < 16; ++r) cc[r] = csl[r]; }
      const char* w0 = lds + WIMG + (64 * s3 + r32) * QL; const char* w1 = w0 + 32 * QL;
#pragma unroll
      for (int ks = 0; ks < 8; ++ks) { const int c = ks * 4 + hi * 2;
        const v8i x0 = __builtin_shufflevector(*reinterpret_cast<const v4i*>(w0 + ((c ^ x15) << 4)), *reinterpret_cast<const v4i*>(w0 + (((c + 1) ^ x15) << 4)), 0, 1, 2, 3, 4, 5, 6, 7);
        const v8i x1 = __builtin_shufflevector(*reinterpret_cast<const v4i*>(w1 + ((c ^ x15) << 4)), *reinterpret_cast<const v4i*>(w1 + (((c + 1) ^ x15) << 4)), 0, 1, 2, 3, 4, 5, 6, 7);
        a0 = __builtin_amdgcn_mfma_scale_f32_32x32x64_f8f6f4(x0, cb[ks], a0, 0, 0, 0, 0, 0, 0);
        a1 = __builtin_amdgcn_mfma_scale_f32_32x32x64_f8f6f4(x1, cb[ks], a1, 0, 0, 0, 0, 0, 0); }
      if (s3 == 2) {
#pragma unroll
        for (int r = 0; r < 16; r += 2) { const f32x2 c0 = cc[r >> 1], c1 = cc[8 + (r >> 1)];
          const float x0 = a0[r], y0 = a0[r + 1], x1 = a1[r], y1 = a1[r + 1];
          a0[r] = x0 * c0.x - y0 * c0.y; a0[r + 1] = y0 * c0.x + x0 * c0.y; a1[r] = x1 * c1.x - y1 * c1.y; a1[r + 1] = y1 * c1.x + x1 * c1.y; } }
#pragma unroll
      for (int q = 0; q < 4; ++q) { int u0 = 0, u1 = 0;
        u0 = __builtin_amdgcn_cvt_pk_fp8_f32(a0[4 * q] * QS, a0[4 * q + 1] * QS, u0, false); u0 = __builtin_amdgcn_cvt_pk_fp8_f32(a0[4 * q + 2] * QS, a0[4 * q + 3] * QS, u0, true);
        u1 = __builtin_amdgcn_cvt_pk_fp8_f32(a1[4 * q] * QS, a1[4 * q + 1] * QS, u1, false); u1 = __builtin_amdgcn_cvt_pk_fp8_f32(a1[4 * q + 2] * QS, a1[4 * q + 3] * QS, u1, true);
        qr[s3][q] = u0; qr[s3][4 + q] = u1; }
    }
    asm volatile("s_waitcnt lgkmcnt(0)" ::: "memory"); __builtin_amdgcn_s_barrier(); asm volatile("" ::: "memory");
  }
  ADMA(1, 1);
  qkt(pA0, pA1, lds + KS(0), qr, r32, hi, nm16); partialSM<true>(pA0, pA1, m_reg, nm16, alA);
  AWAIT(0); ABAR();
  static_assert(NTL == 64, "step pattern below: tiles 1..60 in the loop, 61..63 after it");
#pragma nounroll
  for (int j = 1; j <= 55; j += 6) {
    ASTEP_B(j, 0, 1, 2); ASTEP_A(j + 1, 1, 2, 0); ASTEP_B(j + 2, 2, 0, 1);
    ASTEP_A(j + 3, 0, 1, 2); ASTEP_B(j + 4, 1, 2, 0); ASTEP_A(j + 5, 2, 0, 1);
  }
  ASTEP_B(61, 0, 1, 2); ASTEP_A(62, 1, 2, 0); ASTEP_B(63, 2, 0, 1);
  finishSM(pB0, pB1, alB, l_reg, pa); SBAR();
  pv_d0(o, lds + VS(0), pa, r32, hi);
#undef ASTEP_A
#undef ASTEP_B
  if (hi == 0) li_l[r32] = l_reg; asm volatile("s_waitcnt lgkmcnt(0)" ::: "memory");
  float rli[16];
#pragma unroll
  for (int r = 0; r < 16; ++r) rli[r] = __builtin_amdgcn_rcpf(li_l[crow(r, hi)]);
  bf16* Ow = FP8_WO ? (bf16*)((unsigned char*)Ob + (long)(wid * QBLK) * DM) : Ob + (long)(wid * QBLK) * DM;
#pragma unroll
  for (int r = 0; r < 16; r += 2) {
#pragma unroll
    for (int d0 = 0; d0 < 4; ++d0) {
      const float va = o[d0][r] * rli[r], vb = o[d0][r + 1] * rli[r + 1];
      const float snd = (lane & 1) ? va : vb; const float got = __shfl_xor(snd, 1);
      const int orow = (lane & 1) ? crow(r + 1, hi) : crow(r, hi); const int ocol = d0 * 32 + (r32 & ~1);
      if (FP8_WO) { const int w8 = (lane & 1) ? __builtin_amdgcn_cvt_pk_fp8_f32(got, vb, 0, false) : __builtin_amdgcn_cvt_pk_fp8_f32(va, got, 0, false);
        *(unsigned short*)((unsigned char*)Ow + (long)orow * DM + ocol) = (unsigned short)w8; }
      else { const unsigned w = (lane & 1) ? cvtpk(got, vb) : cvtpk(va, got); *(unsigned*)(Ow + (long)orow * DM + ocol) = w; } }
  }
  asm volatile("s_waitcnt lgkmcnt(0)" ::: "memory"); ABAR();
#undef ADMA
#undef VS
#undef KS
#undef AWAIT
#undef ABAR
#undef RESC
#undef ASTEP
}
#undef KSWZ
}

__device__ __forceinline__ void attn_phase(CArgs& A, unsigned char* lds, int l) {
    constexpr int G = 256;
    const unsigned char* Kb = A.ws + WS_K; const unsigned char* Vb = A.ws + WS_V; bf16* O = (bf16*)(A.ws + WS_O);
    constexpr int NQB = SEQ / 256, NU = NB * NH * NQB;
    const int c = blockIdx.x;
    for (int i = 0; i * G < NU; ++i) {
        int L;
        { const int x = c & 7, j = c >> 3; L = (i * 16 + x * 2 + (j >> 4)) * NQB + (j & 15); }
        if (L >= NU) break;
        const int bh = L / NQB, qb = L % NQB, b = bh / NH, h = bh % NH;
        att::attn_unit(A.ws + WS_CQN + ((size_t)b * SEQ + qb * 256) * QL, A.ws + WS_WUQ + ((size_t)l * NH * DQK + (size_t)h * DQK) * QL, (const f32x2*)(A.ws + WS_CS) + ((size_t)b * SEQ + qb * 256) * 32, Kb + (size_t)bh * SEQ * DQK, Vb + (size_t)bh * SEQ * DV, FP8_WO ? (bf16*)((unsigned char*)(A.ws + WS_O8) + ((size_t)b * SEQ + qb * 256) * DM + h * DV) : O + ((size_t)b * SEQ + qb * 256) * DM + h * DV, (char*)lds);
    }
}

__device__ __forceinline__ void combine_phase(CArgs& A, int l, const float* xin, LAS unsigned char* lds, int vcu, int G) {
    int tid = threadIdx.x; asm volatile("" : "+v"(tid));
    const int lane = tid & 63, wave = __builtin_amdgcn_readfirstlane(tid >> 6);
    const MoeTab T = moe_tables(A, l, lds, false);
    const unsigned* ASG = (const unsigned*)(A.ws + WS_ASG); const float* ASGW = (const float*)(A.ws + WS_ASG + 512 * 1024);
    const unsigned char* OUT2b = A.ws + WS_OUT2; float* X = (float*)(A.ws + WS_X); bf16* H = (bf16*)(A.ws + WS_H);
    const bool lastl = (l == DEPTH - 1);
    for (int t = vcu * NWAVES + wave; t < NT; t += G * NWAVES) {
        const int b = t / SEQ;
        Row x;
        const ModPtr gt = mod_ptr(A, l, b, 5);
#define CB_ISSUE(dst, k0) _Pragma("unroll") for (int k = 0; k < 2; ++k) { const unsigned pk_ = ASG[(size_t)t * 8 + (k0) + k]; const int e = pk_ >> 16, slot = pk_ & 0xffff; const unsigned char* p = OUT2b + ((size_t)T.ts[e] * 256 + slot) * DM + 1024 * hh; \
            _Pragma("unroll") for (int j = 0; j < 2; ++j) dst[k][j] = *(const u32x2*)(p + 512 * j + 8 * lane); }
#define CB_ACC(src, k0) _Pragma("unroll") for (int k = 0; k < 2; ++k) { const float w = ASGW[(size_t)t * 8 + (k0) + k]; \
            _Pragma("unroll") for (int j = 0; j < 2; ++j) { f32x4 a, c; unpack8_fp8(src[k][j], a, c); \
                y[j][0] += w * a.x; y[j][1] += w * a.y; y[j][2] += w * a.z; y[j][3] += w * a.w; y[j][4] += w * c.x; y[j][5] += w * c.y; y[j][6] += w * c.z; y[j][7] += w * c.w; } }
#pragma unroll
        for (int hh = 0; hh < 2; ++hh) {
            u32x2 rs[2], ra[2][2], rb[2][2]; float y[2][8];
            { const unsigned char* p = OUT2b + (size_t)(MAXROWS + t) * DM + 1024 * hh;
#pragma unroll
              for (int j = 0; j < 2; ++j) rs[j] = *(const u32x2*)(p + 512 * j + 8 * lane); }
            CB_ISSUE(ra, 0) CB_ISSUE(rb, 2)
            asm volatile("" ::: "memory");
#pragma unroll
            for (int j = 0; j < 2; ++j) { f32x4 a, c; unpack8_fp8(rs[j], a, c); y[j][0] = a.x; y[j][1] = a.y; y[j][2] = a.z; y[j][3] = a.w; y[j][4] = c.x; y[j][5] = c.y; y[j][6] = c.z; y[j][7] = c.w; }
            CB_ACC(ra, 0)
            asm volatile("" ::: "memory");
            CB_ISSUE(ra, 4)
            asm volatile("" ::: "memory");
            CB_ACC(rb, 2)
            asm volatile("" ::: "memory");
            CB_ISSUE(rb, 6)
            asm volatile("" ::: "memory");
            CB_ACC(ra, 4)
            asm volatile("" ::: "memory");
            f32x4 xv[2][2], gv[2][2];
#pragma unroll
            for (int j = 0; j < 2; ++j)
#pragma unroll
                for (int q4 = 0; q4 < 2; ++q4) { const int c = 1024 * hh + 512 * j + 8 * lane + 4 * q4; xv[j][q4] = *(const f32x4*)(xin + (size_t)t * DM + c); gv[j][q4] = *(const f32x4*)(gt.acc + c); }
            asm volatile("" ::: "memory");
            CB_ACC(rb, 6)
#pragma unroll
            for (int j = 0; j < 2; ++j)
#pragma unroll
                for (int q4 = 0; q4 < 2; ++q4)
#pragma unroll
                    for (int q = 0; q < 4; ++q) x.v[2 * hh + j][4 * q4 + q] = xv[j][q4][q] + gv[j][q4][q] * y[j][4 * q4 + q];
            asm volatile("" ::: "memory");
        }
#undef CB_ISSUE
#undef CB_ACC
        if (!lastl) {
            row_store_f32(x, X + (size_t)t * DM, lane);
            row_norm_mod_store(x, A.in[I_GMIX] + (size_t)(l + 1) * DM, mod_ptr(A, l + 1, b, 0), mod_ptr(A, l + 1, b, 1), H + (size_t)t * DM, lane, A.ws + WS_H8 + (size_t)t * DM);
        } else {
            const float rstd = row_rstd(x); const float* g = A.in[I_GFIN];
#pragma unroll
            for (int j = 0; j < 4; ++j)
#pragma unroll
                for (int q4 = 0; q4 < 2; ++q4) { const int c = 512 * j + 8 * lane + 4 * q4; const f32x4 gv = *(const f32x4*)(g + c);
#pragma unroll
                    for (int q = 0; q < 4; ++q) x.v[j][4 * q4 + q] = x.v[j][4 * q4 + q] * rstd * gv[q]; }
            row_store_f32(x, A.out + (size_t)t * DM, lane);
        }
    }
}

__device__ __forceinline__ CArgs* fresh_args() { CArgs* p = (CArgs*)__builtin_amdgcn_kernarg_segment_ptr(); asm volatile("" : "+s"(p)); return p; }
constexpr int NPH = 2 + 10 * DEPTH;
#ifndef KIND_MASK
#define KIND_MASK 0xfff
#endif
#define KEN(k) ((KIND_MASK >> (k)) & 1)
#ifndef REP_KIND
#define REP_KIND -1
#endif
#ifndef REP_N
#define REP_N 2
#endif
#define REP(k) for (int rep_ = 0; rep_ < ((REP_KIND == (k)) ? REP_N : 1); ++rep_)
#define IN(k) (fresh_args()->ph_lo <= (k) && (k) < fresh_args()->ph_hi)
#define SEAM(k) do { if (IN(k) && IN((k) + 1)) { XcdBarrier bar; bar.bar = (unsigned*)(fresh_args()->ws + WS_CTL) + CW_BAR; bar.x = xb_xcc_id(); bar.st = (volatile LAS unsigned*)(lds + LDS_TAB) + 8; xcd_barrier(bar); } } while (0)
#define PHASE_ARGS() CArgs* A_p = fresh_args(); CArgs& A = *A_p; unsigned char* ws = A.ws; (void)ws;
template <int l> __device__ __forceinline__ void layer_body(LAS unsigned char* lds, unsigned char* lds_raw, int bx, int vcu) {
    constexpr int G = 256;
        const int pb = 2 + 10 * l;
        if (KEN(2) && IN(pb + 0)) REP(2) { PHASE_ARGS();
            const auto mkG = [=]() { unsigned char* ws = fresh_args()->ws; WinP<EpiProj> P; P.A = (const char*)(ws + WS_H8); P.Bt = (const char*)(ws + WS_WIN8) + ((size_t)l * NINP + PC_LA) * DM; P.ord.init(NT / 256, (NINP - PC_LA) / 256, G, bx);
                                     P.e.P = (bf16*)(ws + WS_PROJ); P.e.isc = 1.0f / W13_SCALE; P.e.pn0 = PC_LA / 256; return P; };
            { DenseP<DM, EpiProj> P; P.A = (const char*)(ws + WS_H); P.Bt = (const char*)(ws + WS_WIN) + (size_t)l * NINP * DM * 2; P.ord.init(NT / 256, PC_LA / 256, G, bx); P.e.P = (bf16*)(ws + WS_PROJ); P.e.isc = 1.0f; P.e.pn0 = 0;
              pg::gemm_phase(lds, P, mkG, true, false); }
            { const auto P = mkG();
              pg::gemm_phase(lds, P, pg::NoChain(), false, true); }
        } SEAM(pb + 0);
        if (KEN(3) && IN(pb + 1)) REP(3) { PHASE_ARGS(); postproj_phase(A, l, vcu, G); } SEAM(pb + 1);
        if (KEN(4) && IN(pb + 2)) REP(4) { PHASE_ARGS();
            const auto mkK = [=]() { unsigned char* ws = fresh_args()->ws; DenseP<KVL, EpiK, pg::ListOrder> P; P.A = (const char*)(ws + WS_CKVN); P.Bt = (const char*)(ws + WS_WUKV) + (size_t)l * NH * 128 * KVL * 2; P.ord.nN = NH / 2; P.ord.first = bx; P.ord.n = 1; P.e.Kb = ws + WS_K; return P; };
            const auto mkV = [=]() { unsigned char* ws = fresh_args()->ws; DenseP<KVL, EpiVt, pg::ListOrder> P; P.A = (const char*)(ws + WS_WUKV + 2 * MiB) + (size_t)l * NH * 128 * KVL * 2; P.Bt = (const char*)(ws + WS_CKVN); P.ord.nN = NT / 256; P.ord.first = bx; P.ord.n = 1;
                                     P.e.Vt = ws + WS_V; return P; };
            { DenseP<CW, EpiConv> P; P.A = (const char*)(ws + WS_CZ); P.Bt = (const char*)(ws + WS_WCO) + (size_t)l * DM * CW * 2; P.ord.init(NT / 256, DM / 256, G, bx); P.e.P = (const bf16*)(ws + WS_PROJ); P.e.M1 = (bf16*)(ws + WS_M1);
              pg::gemm_phase(lds, P, mkK, true, false); }
            { const auto P = mkK(); pg::gemm_phase(lds, P, mkV, true, true); }
            { const auto P = mkV(); pg::gemm_phase(lds, P, pg::NoChain(), false, true); }
        } SEAM(pb + 2);
        if (KEN(5) && IN(pb + 3)) REP(5) { PHASE_ARGS(); attn_phase(A, lds_raw, l); } SEAM(pb + 3);
        if (KEN(6) && IN(pb + 4)) REP(6) { PHASE_ARGS();
#if FP8_WO
            WinP<EpiWo> P; P.A = (const char*)(ws + WS_O8); P.Bt = (const char*)(ws + WS_WO8) + (size_t)l * DM * DM; P.e.isc = 1.0f / W13_SCALE;
#else
            DenseP<DM, EpiWo> P; P.A = (const char*)(ws + WS_O); P.Bt = (const char*)(ws + WS_WO) + (size_t)l * DM * DM * 2; P.e.isc = 1.0f;
#endif
            P.ord.init(NT / 256, DM / 256, G, bx);
            P.e.P = (const bf16*)(ws + WS_PROJ); P.e.M1 = (const bf16*)(ws + WS_M1); P.e.MIX = (bf16*)(ws + WS_MIX); P.e.MIX8 = ws + WS_MIX8;
            pg::gemm_phase(lds, P);
        } SEAM(pb + 4);
        if (KEN(7) && IN(pb + 5)) REP(7) { PHASE_ARGS();
#if FP8_WOUT
            WinP<EpiWout> P; P.A = (const char*)(ws + WS_MIX8); P.Bt = (const char*)(ws + WS_WOUT8) + (size_t)l * DM * DM; P.e.isc = 1.0f / W13_SCALE;
#else
            DenseP<DM, EpiWout> P; P.A = (const char*)(ws + WS_MIX); P.Bt = (const char*)(ws + WS_WOUT) + (size_t)l * DM * DM * 2; P.e.isc = 1.0f;
#endif
            P.ord.init(NT / 256, DM / 256, G, bx);
            P.e.xin = (l == 0) ? A.in[I_X] : (const float*)(ws + WS_X); P.e.xout = (float*)(ws + WS_X); P.e.gacc = (const float*)(ws + WS_CTL) + CW_MOD + (size_t)l * NB * (NMOD * DM) + 2 * DM;
            pg::gemm_phase(lds, P);
        } SEAM(pb + 5);
        if (KEN(8) && IN(pb + 6)) { PHASE_ARGS(); nmr_phase(A, (const float*)(ws + WS_X), l, vcu, lds); } SEAM(pb + 6);
        if (KEN(9) && IN(pb + 7)) REP(9) { PHASE_ARGS();
            Moe1P P; P.H = (const char*)(ws + WS_H8); P.W = (const char*)(ws + WS_W13E) + (size_t)l * NE * 1024 * DM; P.WSH = (const char*)(ws + WS_WSH8) + (size_t)l * 1024 * DM; P.LIST = (const int*)(ws + WS_LIST); P.ACT = (bf16*)(ws + WS_ACT); P.SACT = (bf16*)(ws + WS_SACT); P.T = moe_tables(A, l, lds, true); P.G = G; P.c = bx;
            pg::gemm_phase(lds, P);
        } SEAM(pb + 7);
        if (KEN(10) && IN(pb + 8)) REP(10) { PHASE_ARGS();
            Moe2P P; P.ACT = (const char*)(ws + WS_ACT); P.SACT = (const char*)(ws + WS_SACT); P.W = (const char*)(ws + WS_W2E) + (size_t)l * NE * DM * DE; P.WS2 = (const char*)(ws + WS_W2S) + (size_t)l * DM * DS;
            P.OUT2 = (bf16*)(ws + WS_OUT2); P.T = moe_tables(A, l, lds, true); P.G = G; P.c = bx;
            pg::gemm_phase(lds, P);
        } SEAM(pb + 8);
        if (KEN(11) && IN(pb + 9)) REP(11) { PHASE_ARGS(); combine_phase(A, l, (const float*)(ws + WS_X), lds, vcu, G); } SEAM(pb + 9);
}
__global__ void __launch_bounds__(NTHREADS, 2) fwd_kernel(const Args A_unused) {
    extern __shared__ __attribute__((aligned(16))) unsigned char lds_raw[];
    LAS unsigned char* lds = (LAS unsigned char*)lds_raw;
    constexpr int G = 256;
    const int bx = blockIdx.x; const int vcu = (bx % 8) * (G / 8) + bx / 8;
    { volatile LAS unsigned* MISC = (volatile LAS unsigned*)(lds + LDS_TAB);
      const int t0 = otid(); if (t0 < 64) MISC[t0] = 0u;
      __syncthreads();
      CArgs* A0 = fresh_args();
      if (A0->ph_hi - A0->ph_lo > 1) (void)xcd_barrier_post((unsigned*)(A0->ws + WS_CTL) + CW_BAR, MISC + 8); }
    if (KEN(0) && IN(0)) REP(0) { PHASE_ARGS(); prologue_phase(A, lds, vcu, G); } SEAM(0);
    if (KEN(1) && IN(1)) REP(1) { PHASE_ARGS(); norm_mod_phase(A, A.in[I_X], A.in[I_GMIX], 0, 0, 1, vcu, G); } SEAM(1);
    layer_body<0>(lds, lds_raw, bx, vcu);
    layer_body<1>(lds, lds_raw, bx, vcu);
#undef IN
#undef SEAM
#undef PHASE_ARGS
}

#ifndef N_LAUNCH_MODE
#define N_LAUNCH_MODE 0
#endif
extern "C" void kernel_launch(void* const* d_in, const int* in_sizes, int n_in, void* d_out, int out_size, void* d_ws, size_t ws_size, hipStream_t stream) {
    static int grid = 0;
    if (grid == 0) {
        if (n_in != 25 || out_size != NT * DM || ws_size < WS_END) { fprintf(stderr, "kernel_launch: unexpected shapes: n_in %d out %d ws %zu (need %zu)\n", n_in, out_size, ws_size, (size_t)WS_END); grid = -1; return; }
        int dev = 0, cus = 0, per_cu = 0;
        if (hipGetDevice(&dev) != hipSuccess || hipDeviceGetAttribute(&cus, hipDeviceAttributeMultiprocessorCount, dev) != hipSuccess) { grid = -1; return; }
        if (hipFuncSetAttribute((const void*)fwd_kernel, hipFuncAttributeMaxDynamicSharedMemorySize, LDS_BYTES) != hipSuccess) { fprintf(stderr, "kernel_launch: hipFuncSetAttribute failed\n"); grid = -1; return; }
        if (hipOccupancyMaxActiveBlocksPerMultiprocessor(&per_cu, (const void*)fwd_kernel, NTHREADS, LDS_BYTES) != hipSuccess || per_cu < 1) { fprintf(stderr, "kernel_launch: occupancy query says %d\n", per_cu); }
        (void)hipGetLastError();
        if (cus != 256) fprintf(stderr, "kernel_launch: built for a 256-CU device, found %d CUs\n", cus);
        grid = 256;
    }
    if (grid < 0) return;
    (void)hipMemsetAsync((char*)d_ws + WS_CTL + (size_t)CW_BAR * 4, 0, (size_t)(CW_CNT + DEPTH * 64 - CW_BAR) * 4, stream);
    Args a{};
    for (int i = 0; i < 25; ++i) a.in[i] = (const float*)d_in[i];
    a.out = (float*)d_out; a.ws = (unsigned char*)d_ws;
#if N_LAUNCH_MODE == 0
    a.ph_lo = 0; a.ph_hi = NPH;
    hipLaunchKernelGGL(fwd_kernel, dim3(grid), dim3(NTHREADS), LDS_BYTES, stream, a);
#else
    for (int p = 0; p < NPH; ++p) { a.ph_lo = p; a.ph_hi = p + 1; hipLaunchKernelGGL(fwd_kernel, dim3(grid), dim3(NTHREADS), LDS_BYTES, stream, a); }
#endif
    const hipError_t le = hipPeekAtLastError();
    if (le != hipSuccess) fprintf(stderr, "kernel_launch: launch failed: %s\n", hipGetErrorName(le));
}
```

```cpp
#include <hip/hip_runtime.h>
#include <cstdio>
#include <cstdint>
#include <cmath>

#define LAS __attribute__((address_space(3)))
#define GAS __attribute__((address_space(1)))
typedef unsigned short bf16;
typedef short bf16x8 __attribute__((ext_vector_type(8)));
typedef short s16x4 __attribute__((ext_vector_type(4)));
typedef float f32x4 __attribute__((ext_vector_type(4)));
typedef float f32x2 __attribute__((ext_vector_type(2)));
typedef float f32x16 __attribute__((ext_vector_type(16)));
typedef unsigned u32x4 __attribute__((ext_vector_type(4)));
typedef unsigned u32x2 __attribute__((ext_vector_type(2)));

constexpr int DM = 2048, NB = 2, SEQ = 4096, NT = NB * SEQ, DEPTH = 2;
constexpr int NH = 16, QL = 512, KVL = 256, DNOPE = 128, DROPE = 64, DV = 128, DQK = 192;
constexpr int CW = 1024, NE = 64, TOPK = 8, DE = 512, DS = 512;
constexpr int NIN = 8000, NINP = 8192;
constexpr int NMOD = 6;
constexpr float EPS = 1e-6f;
constexpr int NWAVES = 8, NTHREADS = 512;
constexpr int PC_CQ = 0, PC_CKV = 512, PC_KPE = 768, PC_GB = 1024, PC_GC = 2048, PC_U = 3072, PC_LA = 4096, PC_LC = 6144;
constexpr int MAXROWS = 65536 + 64 * 256;
constexpr int WSR_ROWS = 1280;

constexpr size_t MiB = 1u << 20;
constexpr size_t WS_CTL = 0, CTL_BYTES = 1 * MiB;
constexpr size_t WS_CS = 2 * MiB;
constexpr size_t WS_WIN = 4 * MiB;
constexpr size_t WS_WUQ = WS_WIN + 64 * MiB;
constexpr size_t WS_WUKV = WS_WUQ + 6 * MiB;
constexpr size_t WS_WO = WS_WUKV + 4 * MiB;
constexpr size_t WS_WCO = WS_WO + 16 * MiB;
constexpr size_t WS_WOUT = WS_WCO + 8 * MiB;
constexpr size_t WS_WSR = WS_WOUT + 16 * MiB;
constexpr size_t WS_W2S = WS_WSR + 10 * MiB;
constexpr size_t WS_W13E = WS_W2S + 4 * MiB;
constexpr size_t WS_W2E = WS_W13E + 512 * MiB;
constexpr size_t WS_WSH8 = WS_W2E + 128 * MiB;
constexpr size_t WS_H8 = WS_W2E + 136 * MiB;
constexpr size_t WS_WIN8 = WS_W2E + 160 * MiB;
constexpr size_t WS_WO8 = WS_W2E + 192 * MiB;
constexpr size_t WS_WOUT8 = WS_W2E + 200 * MiB;
constexpr size_t WS_O8 = WS_W2E + 208 * MiB;
constexpr size_t WS_MIX8 = WS_W2E + 224 * MiB;
constexpr size_t WS_X = WS_W2E + 256 * MiB;
constexpr size_t WS_H = WS_X + 64 * MiB;
constexpr size_t WS_T = WS_H + 32 * MiB;
constexpr size_t WS_PROJ = WS_T;
constexpr size_t WS_CQN = WS_PROJ + 128 * MiB;
constexpr size_t WS_CKVN = WS_CQN + 8 * MiB;
constexpr size_t WS_CZ = WS_CKVN + 4 * MiB;
constexpr size_t WS_Q = WS_CZ + 16 * MiB;
constexpr size_t WS_K = WS_Q + 48 * MiB;
constexpr size_t WS_V = WS_K + 48 * MiB;
constexpr size_t WS_O = WS_V + 32 * MiB;
constexpr size_t WS_M1 = WS_O + 32 * MiB;
constexpr size_t WS_MIX = WS_M1 + 32 * MiB;
constexpr size_t WS_MIXER_END = WS_MIX + 32 * MiB;
constexpr size_t WS_SACT = WS_T;
constexpr size_t WS_LOGIT = WS_SACT + 8 * MiB;
constexpr size_t WS_LIST = WS_LOGIT + 2 * MiB;
constexpr size_t WS_ASG = WS_LIST + 2 * MiB;
constexpr size_t WS_ACT = WS_ASG + 1 * MiB;
constexpr size_t WS_OUT2 = WS_ACT + 80 * MiB;
constexpr size_t WS_MOE_END = WS_OUT2 + (size_t)(MAXROWS + NT) * DM * 2;
constexpr size_t WS_END = (WS_MOE_END > WS_MIXER_END ? WS_MOE_END : WS_MIXER_END);
constexpr int CW_BAR = 4096;
constexpr int CW_WQ = 7680;
constexpr int CW_CNT = 8192;
constexpr int CW_MOD = 16384;
static_assert((CW_MOD + DEPTH * NB * NMOD * DM) * 4 <= (int)CTL_BYTES, "ctl");

constexpr int RING_BYTES = 131072;
constexpr int LDS_TAB = RING_BYTES;
constexpr int LDS_BYTES = 147456;

#define LDS_WAIT() asm volatile("s_waitcnt lgkmcnt(0)" ::: "memory")
#define VM_WAIT() asm volatile("s_waitcnt vmcnt(0)" ::: "memory")
#define RLX_AGENT __ATOMIC_RELAXED, __HIP_MEMORY_SCOPE_AGENT

__device__ __forceinline__ unsigned cvtpk(float lo, float hi) { unsigned r; asm volatile("v_cvt_pk_bf16_f32 %0, %1, %2" : "=v"(r) : "v"(lo), "v"(hi)); return r; }
__device__ __forceinline__ float bflo(unsigned w) { return __uint_as_float(w << 16); }
__device__ __forceinline__ float bfhi(unsigned w) { return __uint_as_float(w & 0xffff0000u); }
__device__ __forceinline__ float sigmoidf_(float v) { return __builtin_amdgcn_rcpf(1.0f + __expf(-v)); }
__device__ __forceinline__ float siluf_(float v) { return v * sigmoidf_(v); }
__device__ __forceinline__ int otid() { int t = threadIdx.x; asm volatile("" : "+v"(t)); return t; }
template <int CTRL> __device__ __forceinline__ float dpp_f(float v) { return __int_as_float(__builtin_amdgcn_update_dpp(0, __float_as_int(v), CTRL, 0xf, 0xf, true)); }
__device__ __forceinline__ float readlane_f(float v, int l) { return __int_as_float(__builtin_amdgcn_readlane(__float_as_int(v), l)); }
__device__ __forceinline__ float wave_sum(float v) {
    v += dpp_f<0xB1>(v); v += dpp_f<0x4E>(v); v += dpp_f<0x141>(v); v += dpp_f<0x140>(v);
    return (readlane_f(v, 0) + readlane_f(v, 16)) + (readlane_f(v, 32) + readlane_f(v, 48));
}

#define XB_TMO      128
#define XB_XCNT(j)  (256  + 64 * (j))
#define XB_XSUB(j)  (1280 + 64 * (j))
#define XB_XGEN(j)  (2304 + 64 * (j))
#define XB_TOP      3328
#define XB_TOPGEN   3392
#define XCD_BAR_WORDS 3456
#define XB_SPIN_CAP (1u << 22)

__device__ __forceinline__ unsigned xb_ld(unsigned* p)              { return __hip_atomic_load(p, __ATOMIC_RELAXED, __HIP_MEMORY_SCOPE_AGENT); }
__device__ __forceinline__ unsigned xb_add(unsigned* p, unsigned v) { return __hip_atomic_fetch_add(p, v, __ATOMIC_RELAXED, __HIP_MEMORY_SCOPE_AGENT); }
__device__ __forceinline__ unsigned xb_xcc_id() { return (unsigned)__builtin_amdgcn_s_getreg((3 << 11) | 20) & 0xFu; }
#define XB_SPIN(cond, bar) do { unsigned _sp = 0; while (cond) { __builtin_amdgcn_s_sleep(1); \
    if ((++_sp & 255u) == 0u) { if (xb_ld(&(bar)[XB_TMO])) break; if (_sp > XB_SPIN_CAP) { atomicAdd(&(bar)[XB_TMO], 1u); break; } } } } while (0)

struct XcdBarrier { unsigned* bar; unsigned x; volatile LAS unsigned* st; };

__device__ __forceinline__ XcdBarrier xcd_barrier_post(unsigned* bar, volatile LAS unsigned* st) {
    XcdBarrier b; b.bar = bar; b.x = xb_xcc_id(); b.st = st;
    if (otid() == 0) (void)xb_add(&bar[XB_XCNT(b.x)], 1u);
    return b;
}
__device__ __forceinline__ void xcd_barrier_complete(unsigned* bar, unsigned x, unsigned& nloc, unsigned& nx) {
    const unsigned G = gridDim.x * gridDim.y * gridDim.z;
    unsigned sum, cnt, mine, sp = 0u;
    for (;;) {
        sum = 0u; cnt = 0u; mine = 0u;
#pragma unroll
        for (unsigned j = 0; j < 16; ++j) { const unsigned c = xb_ld(&bar[XB_XCNT(j)]); sum += c; cnt += (c > 0u) ? 1u : 0u; mine = (j == x) ? c : mine; }
        if (sum == G) break;
        __builtin_amdgcn_s_sleep(1);
        if ((++sp & 255u) == 0u) { if (xb_ld(&bar[XB_TMO])) break; if (sp > XB_SPIN_CAP) { atomicAdd(&bar[XB_TMO], 1u); break; } }
    }
    nloc = mine > 0u ? mine : 1u; nx = cnt > 0u ? cnt : 1u;
}
__device__ __forceinline__ void xcd_barrier(const XcdBarrier& b) {
    asm volatile("s_waitcnt vmcnt(0)" ::: "memory");
    __syncthreads();
    if (otid() == 0) {
        unsigned* bar = b.bar;
        __builtin_amdgcn_s_waitcnt(0);
        unsigned nloc = b.st[0], nx = b.st[1];
        if (nloc == 0u) { xcd_barrier_complete(bar, b.x, nloc, nx); b.st[0] = nloc; b.st[1] = nx; }
        const unsigned old = xb_add(&bar[XB_XSUB(b.x)], 1u);
        const unsigned gen = old / nloc;
        if (old + 1u == (gen + 1u) * nloc) {
            __builtin_amdgcn_fence(__ATOMIC_RELEASE, "agent");
            asm volatile("s_waitcnt vmcnt(0)" ::: "memory");
            const unsigned og = xb_add(&bar[XB_TOP], 1u);
            const unsigned tg = og / nx;
            if (og + 1u == (tg + 1u) * nx) xb_add(&bar[XB_TOPGEN], 1u);
            else XB_SPIN(xb_ld(&bar[XB_TOPGEN]) == tg, bar);
            __builtin_amdgcn_fence(__ATOMIC_ACQUIRE, "agent");
            xb_add(&bar[XB_XGEN(b.x)], 1u);
            asm volatile("s_waitcnt vmcnt(0)" ::: "memory");
        } else {
            XB_SPIN(xb_ld(&bar[XB_XGEN(b.x)]) == gen, bar);
            __builtin_amdgcn_fence(__ATOMIC_ACQUIRE, "agent");
            asm volatile("s_waitcnt vmcnt(0)" ::: "memory");
        }
    }
    __syncthreads();
}

struct Args {
    const float* in[25];
    float* out; unsigned char* ws;
    int ph_lo, ph_hi;
};
__device__ const float inv_freq_tab[32] = {1.000000000e+00f, 7.498942018e-01f, 5.623413324e-01f, 4.216965139e-01f, 3.162277639e-01f, 2.371373922e-01f, 1.778279394e-01f, 1.333521456e-01f, 1.000000015e-01f, 7.498941571e-02f, 5.623412877e-02f, 4.216964915e-02f, 3.162277862e-02f, 2.371373586e-02f, 1.778279431e-02f, 1.333521493e-02f, 9.999999776e-03f, 7.498942316e-03f, 5.623413250e-03f, 4.216964822e-03f, 3.162277862e-03f, 2.371373819e-03f, 1.778279431e-03f, 1.333521446e-03f, 1.000000047e-03f, 7.498941850e-04f, 5.623413017e-04f, 4.216965463e-04f, 3.162277862e-04f, 2.371373848e-04f, 1.778279402e-04f, 1.333521504e-04f};
typedef const __attribute__((address_space(4))) Args CArgs;
enum { I_X = 0, I_C, I_POS, I_WADA, I_BADA, I_GMIX, I_WIN, I_GQ, I_WUQ, I_GKV, I_WUKV, I_WOA, I_CONVW, I_WCO, I_WOUT, I_GFFN, I_WR, I_BR, I_W1E, I_W3E, I_W2E, I_W1S, I_W3S, I_W2S, I_GFIN };

namespace pg {
constexpr int BM = 256, BK = 64, HALF = 128, HTB = HALF * BK * 2;
__device__ __forceinline__ int lds_byte(int r, int c) { return r * 128 + ((((c >> 3) ^ ((r >> 1) & 7))) << 4) + (c & 7) * 2; }
__device__ __forceinline__ void stage_rc(int b, int& R, int& C) { R = b >> 7; C = ((((b & 127) >> 4) ^ ((R >> 1) & 7))) << 3; }
__device__ __forceinline__ int perm32(int rho) { const int n = rho >> 4, i = rho & 15; return 8 * (i >> 2) + 4 * n + (i & 3); }
struct Unit { int pm, pn, aux, aux2, half; };
typedef f32x4 Acc[2][2][4][2];

template <class T, class = void> struct peel_of { static constexpr bool value = false; };
template <class T> struct peel_of<T, decltype((void)T::PEEL)> { static constexpr bool value = T::PEEL; };
template <class T, class = void> struct bmode_of { static constexpr int value = 0; };
template <class T> struct bmode_of<T, decltype((void)T::BMODE)> { static constexpr int value = T::BMODE; };
struct NoChainP { static constexpr int LDA = 0, LDB = 0; static constexpr bool FP8 = false, PERM = false, GATHER = false;
    __device__ __forceinline__ bool next(int, Unit&) const { return false; } __device__ __forceinline__ const char* a_base(const Unit&) const { return nullptr; } __device__ __forceinline__ const char* b_base(const Unit&) const { return nullptr; }
    __device__ __forceinline__ void a_offsets(const Unit&, unsigned (&)[2][2]) const {} };
struct NoChain { __device__ __forceinline__ NoChainP operator()() const { return NoChainP(); } };
template <class P, class MK = NoChain>
__device__ __forceinline__ void gemm_phase(LAS unsigned char* lds, const P& p, const MK& mk = MK(), bool chain_out = false, bool chained_in = false) {
    constexpr bool CHAIN = !__is_same(MK, NoChain);
    constexpr bool PEEL = peel_of<P>::value;
    constexpr bool FP8 = P::FP8; constexpr int ES = FP8 ? 1 : 2;
    constexpr int K = P::K, nt = K * ES / 128, LDA = P::LDA, LDB = P::LDB;
    static_assert((K * ES) % 256 == 0 && K * ES >= 512, "K");
    int tid = threadIdx.x; asm volatile("" : "+v"(tid));
    const int wid = __builtin_amdgcn_readfirstlane(tid >> 6), lane = tid & 63, wr = wid >> 2, wc = wid & 3, fr = lane & 15, fq = lane >> 4;
    unsigned voffB[2], vA[2][2], nvA[2][2], nvB[2]; typedef decltype(mk()) NP; constexpr int NES = NP::FP8 ? 1 : 2; constexpr int NBMODE = bmode_of<NP>::value; constexpr size_t nhstepB = (size_t)(NBMODE == 1 ? 8 : (NBMODE == 2 ? 16 : HALF)) * NP::LDB * NES;
    constexpr size_t kstep = (size_t)(BK * 2);
    constexpr int BMODE = bmode_of<P>::value;
    constexpr size_t hstep = (size_t)(BMODE == 1 ? 8 : (BMODE == 2 ? 16 : HALF)) * LDB * ES, hstepA = (size_t)HALF * LDA * ES;
#pragma unroll
    for (int i = 0; i < 2; ++i) { int R, C; stage_rc(tid * 16 + i * 8192, R, C); const int rho_ = R & 31;
        const int fq_ = (rho_ & 15) >> 2, n_ = rho_ >> 4, q_ = rho_ & 3;
        const int Rb = BMODE == 1 ? ((R >> 5) * 64 + fq_ * 16 + 4 * n_ + q_) : (BMODE == 2 ? ((R >> 5) * 64 + 32 * (fq_ >> 1) + 8 * n_ + 4 * (fq_ & 1) + q_) : (P::PERM ? ((R & ~31) + perm32(R & 31)) : R));
        voffB[i] = (unsigned)(Rb * LDB * ES + C * 2); vA[0][i] = (unsigned)(R * LDA * ES + C * 2); vA[1][i] = vA[0][i] + (unsigned)hstepA; nvA[0][i] = vA[0][i]; nvA[1][i] = vA[1][i]; nvB[i] = voffB[i]; }
    const unsigned ldsw = (unsigned)wid * 1024u;
    const int aoff = lds_byte(wr * 64 + fr, fq * 8), boff = lds_byte(wc * 32 + fr, fq * 8); const int aoff1 = aoff ^ 64, boff1 = boff ^ 64;
#define PG_SA(b, h) (((b) * 2 + (h)) * HTB)
#define PG_SB(b, h) ((4 + (b) * 2 + (h)) * HTB)
#define PG_STAGE(bufoff, gbase, voff) do { const char* gb_ = (const char*)(gbase); asm volatile("" : "+s"(gb_));     \
        _Pragma("unroll") for (int _i = 0; _i < 2; ++_i) \
        __builtin_amdgcn_global_load_lds((const unsigned*)(gb_ + (voff)[_i]), (LAS unsigned*)(lds + (bufoff) + ldsw + _i * 8192), 16, 0, 0); } while (0)
#define PG_LD8(p0_, p1_) __builtin_shufflevector(*(const LAS v4i_*)(p0_), *(const LAS v4i_*)(p1_), 0, 1, 2, 3, 4, 5, 6, 7)
#define PG_LDA(dst, b, h) do { if constexpr (FP8) { _Pragma("unroll") for (int m = 0; m < 4; ++m) dst##8[m] = PG_LD8(lds + PG_SA(b, h) + aoff + m * 2048, lds + PG_SA(b, h) + aoff1 + m * 2048); } \
        else { _Pragma("unroll") for (int m = 0; m < 4; ++m) _Pragma("unroll") for (int k = 0; k < 2; ++k) dst[m][k] = *(const LAS bf16x8*)(lds + PG_SA(b, h) + (k ? aoff1 : aoff) + m * 2048); } } while (0)
#define PG_LDB(dst, b, h) do { if constexpr (FP8) { _Pragma("unroll") for (int n = 0; n < 2; ++n) dst##8[n] = PG_LD8(lds + PG_SB(b, h) + boff + n * 2048, lds + PG_SB(b, h) + boff1 + n * 2048); } \
        else { _Pragma("unroll") for (int n = 0; n < 2; ++n) _Pragma("unroll") for (int k = 0; k < 2; ++k) dst[n][k] = *(const LAS bf16x8*)(lds + PG_SB(b, h) + (k ? boff1 : boff) + n * 2048); } } while (0)
#define PG_MMA(ai, bj, At, Bt) do { __builtin_amdgcn_s_setprio(1); _Pragma("unroll") for (int m = 0; m < 4; ++m) _Pragma("unroll") for (int n = 0; n < 2; ++n) { \
        if constexpr (FP8) acc[ai][bj][m][n] = __builtin_amdgcn_mfma_scale_f32_16x16x128_f8f6f4(Bt##8[n], At##8[m], acc[ai][bj][m][n], 0, 0, 0, 0, 0, 0); \
        else { _Pragma("unroll") for (int k = 0; k < 2; ++k) acc[ai][bj][m][n] = __builtin_amdgcn_mfma_f32_16x16x32_bf16(Bt[n][k], At[m][k], acc[ai][bj][m][n], 0, 0, 0); } } \
        __builtin_amdgcn_s_setprio(0); } while (0)
#define PG_MMAZ(ai, bj, At, Bt) do { const f32x4 z4_ = {0.f, 0.f, 0.f, 0.f}; __builtin_amdgcn_s_setprio(1); _Pragma("unroll") for (int m = 0; m < 4; ++m) _Pragma("unroll") for (int n = 0; n < 2; ++n) { \
        if constexpr (FP8) acc[ai][bj][m][n] = __builtin_amdgcn_mfma_scale_f32_16x16x128_f8f6f4(Bt##8[n], At##8[m], z4_, 0, 0, 0, 0, 0, 0); \
        else { acc[ai][bj][m][n] = __builtin_amdgcn_mfma_f32_16x16x32_bf16(Bt[n][0], At[m][0], z4_, 0, 0, 0); acc[ai][bj][m][n] = __builtin_amdgcn_mfma_f32_16x16x32_bf16(Bt[n][1], At[m][1], acc[ai][bj][m][n], 0, 0, 0); } } \
        __builtin_amdgcn_s_setprio(0); } while (0)
#define PG_WAIT_V(n) asm volatile("s_waitcnt vmcnt(" #n ")" ::: "memory")
#define PG_WAIT_L(n) asm volatile("s_waitcnt lgkmcnt(" #n ")" ::: "memory")
#define PG_BAR __builtin_amdgcn_s_barrier()
#define PG_SCHED __builtin_amdgcn_sched_barrier(0)
    Unit cur, nxt; int ui = 0;
    if (!p.next(0, cur)) return;
    Acc acc;
    if constexpr (!PEEL) {
#pragma unroll
    for (int a = 0; a < 2; ++a)
#pragma unroll
        for (int b = 0; b < 2; ++b)
#pragma unroll
            for (int m = 0; m < 4; ++m)
#pragma unroll
                for (int n = 0; n < 2; ++n) { typedef double d2_ __attribute__((ext_vector_type(2))); d2_ z_; asm volatile("v_mov_b64 %0, 0" : "=v"(z_.x)); asm volatile("v_mov_b64 %0, 0" : "=v"(z_.y)); acc[a][b][m][n] = __builtin_bit_cast(f32x4, z_); }
    }
    typedef int v8i_ __attribute__((ext_vector_type(8))); typedef int v4i_ __attribute__((ext_vector_type(4)));
    bf16x8 At[4][2], B0[2][2], B1[2][2]; v8i_ At8[4], B08[2], B18[2];
    const char* cA = p.a_base(cur); const char* cB = p.b_base(cur);
    if constexpr (P::GATHER) { p.a_offsets(cur, vA); }
    if (!chained_in) {
    PG_STAGE(PG_SB(0, 0), cB, voffB); PG_STAGE(PG_SA(0, 0), cA, vA[0]); PG_STAGE(PG_SB(0, 1), cB + hstep, voffB); PG_STAGE(PG_SA(0, 1), cA, vA[1]);
    if (wr == 1) PG_BAR;
    PG_WAIT_V(4); PG_BAR;
    PG_STAGE(PG_SB(1, 0), cB + kstep, voffB); PG_STAGE(PG_SA(1, 0), cA + kstep, vA[0]); PG_STAGE(PG_SB(1, 1), cB + hstep + kstep, voffB);
    PG_WAIT_V(6); PG_BAR;
    }
    for (;;) {
        const bool has_next = p.next(ui + 1, nxt);
        const char* nA = has_next ? p.a_base(nxt) : cA; const char* nB = has_next ? p.b_base(nxt) : cB;
        const bool chain_now = CHAIN && chain_out && !has_next;
        if constexpr (CHAIN) { if (chain_now) { const auto np = mk(); Unit nu; (void)np.next(0, nu); nA = np.a_base(nu); nB = np.b_base(nu); } }
        const bool full = P::HALF ? (cur.half == 0) : true;
#define PG_STAGE_A2(bufoff, gbase, h) do { if ((P::GATHER && last) || chl) PG_STAGE(bufoff, gbase, nvA[h]); else PG_STAGE(bufoff, gbase, vA[h]); } while (0)
#define PG_STAGE_B2(bufoff, gbase, h) do { if (chl) PG_STAGE(bufoff, (gbase) + (h) * nhstepB, nvB); else PG_STAGE(bufoff, (gbase) + (h) * hstep, voffB); } while (0)
        if constexpr (PEEL) {
            constexpr int t = 0;
            const bool last = (t == nt - 2);
            const char* a1 = cA + (size_t)(t + 1) * kstep;
            const char* a2 = last ? nA : cA + (size_t)(t + 2) * kstep; const char* b2 = last ? nB : cB + (size_t)(t + 2) * kstep;
            const char* a3 = a2 + kstep; const char* b3 = b2 + kstep;
            if constexpr (P::GATHER) {
                if (last && has_next) p.a_offsets(nxt, nvA);
                if (last && !has_next && !chain_now) {
#pragma unroll
                    for (int h = 0; h < 2; ++h)
#pragma unroll
                        for (int i = 0; i < 2; ++i) nvA[h][i] = vA[h][i]; }
            }
            if constexpr (CHAIN) {
                if (last && chain_now) {
                    if constexpr (NP::GATHER) { const auto np = mk(); Unit nu; (void)np.next(0, nu); np.a_offsets(nu, nvA); }
#pragma unroll
                    for (int i = 0; i < 2; ++i) { int R, C; stage_rc(tid * 16 + i * 8192, R, C); const int rho_ = R & 31, fq_ = (rho_ & 15) >> 2, n_ = rho_ >> 4, q_ = rho_ & 3;
                        const int Rb = NBMODE == 1 ? ((R >> 5) * 64 + fq_ * 16 + 4 * n_ + q_) : (NBMODE == 2 ? ((R >> 5) * 64 + 32 * (fq_ >> 1) + 8 * n_ + 4 * (fq_ & 1) + q_) : (NP::PERM ? ((R & ~31) + perm32(R & 31)) : R));
                        nvB[i] = (unsigned)(Rb * NP::LDB * NES + C * 2);
                        if constexpr (!NP::GATHER) { nvA[0][i] = (unsigned)(R * NP::LDA * NES + C * 2); nvA[1][i] = nvA[0][i] + (unsigned)((size_t)HALF * NP::LDA * NES); } }
                }
            }
            const bool chl = CHAIN && last && chain_now;
            PG_LDB(B0, 0, 0); PG_SCHED; PG_LDA(At, 0, 0); PG_STAGE(PG_SA(1, 1), a1, vA[1]);
            PG_WAIT_L(8); PG_BAR; PG_WAIT_L(0); PG_MMAZ(0, 0, At, B0); PG_BAR; PG_SCHED;
            PG_LDB(B1, 0, 1); PG_STAGE_B2(PG_SB(0, 0), b2, 0);
            PG_BAR; PG_WAIT_L(0); PG_MMAZ(0, 1, At, B1); PG_BAR;
            if (full) PG_LDA(At, 0, 1); PG_STAGE_A2(PG_SA(0, 0), a2, 0);
            PG_BAR; PG_WAIT_L(0); if (full) PG_MMAZ(1, 0, At, B0); PG_BAR; PG_SCHED;
            PG_STAGE_B2(PG_SB(0, 1), b2, 1);
            PG_WAIT_V(6); PG_BAR; if (full) PG_MMAZ(1, 1, At, B1); PG_BAR;
            PG_LDB(B0, 1, 0); PG_SCHED; PG_LDA(At, 1, 0); PG_STAGE_A2(PG_SA(0, 1), a2, 1);
            PG_WAIT_L(8); PG_BAR; PG_WAIT_L(0); PG_MMA(0, 0, At, B0); PG_BAR; PG_SCHED;
            PG_LDB(B1, 1, 1); PG_STAGE_B2(PG_SB(1, 0), b3, 0);
            PG_BAR; PG_WAIT_L(0); PG_MMA(0, 1, At, B1); PG_BAR;
            if (full) PG_LDA(At, 1, 1); PG_STAGE_A2(PG_SA(1, 0), a3, 0);
            PG_BAR; PG_WAIT_L(0); if (full) PG_MMA(1, 0, At, B0); PG_BAR; PG_SCHED;
            PG_STAGE_B2(PG_SB(1, 1), b3, 1);
            PG_WAIT_V(6); PG_BAR; if (full) PG_MMA(1, 1, At, B1); PG_BAR;

        }
#pragma nounroll
        for (int t = PEEL ? 2 : 0; t < nt; t += 2) {
            const bool last = (t == nt - 2);
            const char* a1 = cA + (size_t)(t + 1) * kstep;
            const char* a2 = last ? nA : cA + (size_t)(t + 2) * kstep; const char* b2 = last ? nB : cB + (size_t)(t + 2) * kstep;
            const char* a3 = a2 + kstep; const char* b3 = b2 + kstep;
            if constexpr (P::GATHER) {
                if (last && has_next) p.a_offsets(nxt, nvA);
                if (last && !has_next && !chain_now) {
#pragma unroll
                    for (int h = 0; h < 2; ++h)
#pragma unroll
                        for (int i = 0; i < 2; ++i) nvA[h][i] = vA[h][i]; }
            }
            if constexpr (CHAIN) {
                if (last && chain_now) {
                    if constexpr (NP::GATHER) { const auto np = mk(); Unit nu; (void)np.next(0, nu); np.a_offsets(nu, nvA); }
#pragma unroll
                    for (int i = 0; i < 2; ++i) { int R, C; stage_rc(tid * 16 + i * 8192, R, C); const int rho_ = R & 31, fq_ = (rho_ & 15) >> 2, n_ = rho_ >> 4, q_ = rho_ & 3;
                        const int Rb = NBMODE == 1 ? ((R >> 5) * 64 + fq_ * 16 + 4 * n_ + q_) : (NBMODE == 2 ? ((R >> 5) * 64 + 32 * (fq_ >> 1) + 8 * n_ + 4 * (fq_ & 1) + q_) : (NP::PERM ? ((R & ~31) + perm32(R & 31)) : R));
                        nvB[i] = (unsigned)(Rb * NP::LDB * NES + C * 2);
                        if constexpr (!NP::GATHER) { nvA[0][i] = (unsigned)(R * NP::LDA * NES + C * 2); nvA[1][i] = nvA[0][i] + (unsigned)((size_t)HALF * NP::LDA * NES); } }
                }
            }
            const bool chl = CHAIN && last && chain_now;
            PG_LDB(B0, 0, 0); PG_SCHED; PG_LDA(At, 0, 0); PG_STAGE(PG_SA(1, 1), a1, vA[1]);
            PG_WAIT_L(8); PG_BAR; PG_WAIT_L(0); PG_MMA(0, 0, At, B0); PG_BAR; PG_SCHED;
            PG_LDB(B1, 0, 1); PG_STAGE_B2(PG_SB(0, 0), b2, 0);
            PG_BAR; PG_WAIT_L(0); PG_MMA(0, 1, At, B1); PG_BAR;
            if (full) PG_LDA(At, 0, 1); PG_STAGE_A2(PG_SA(0, 0), a2, 0);
            PG_BAR; PG_WAIT_L(0); if (full) PG_MMA(1, 0, At, B0); PG_BAR; PG_SCHED;
            PG_STAGE_B2(PG_SB(0, 1), b2, 1);
            PG_WAIT_V(6); PG_BAR; if (full) PG_MMA(1, 1, At, B1); PG_BAR;
            PG_LDB(B0, 1, 0); PG_SCHED; PG_LDA(At, 1, 0); PG_STAGE_A2(PG_SA(0, 1), a2, 1);
            PG_WAIT_L(8); PG_BAR; PG_WAIT_L(0); PG_MMA(0, 0, At, B0); PG_BAR; PG_SCHED;
            PG_LDB(B1, 1, 1); PG_STAGE_B2(PG_SB(1, 0), b3, 0);
            PG_BAR; PG_WAIT_L(0); PG_MMA(0, 1, At, B1); PG_BAR;
            if (full) PG_LDA(At, 1, 1); PG_STAGE_A2(PG_SA(1, 0), a3, 0);
            PG_BAR; PG_WAIT_L(0); if (full) PG_MMA(1, 0, At, B0); PG_BAR; PG_SCHED;
            PG_STAGE_B2(PG_SB(1, 1), b3, 1);
            PG_WAIT_V(6); PG_BAR; if (full) PG_MMA(1, 1, At, B1); PG_BAR;

        }
        p.epi(acc, cur, wr, wc, fr, fq);
        if (!has_next) break;
    if constexpr (!PEEL) {
#pragma unroll
        for (int a = 0; a < 2; ++a)
#pragma unroll
            for (int b = 0; b < 2; ++b)
#pragma unroll
                for (int m = 0; m < 4; ++m)
#pragma unroll
                    for (int n = 0; n < 2; ++n) { typedef double d2_ __attribute__((ext_vector_type(2))); d2_ z_; asm volatile("v_mov_b64 %0, 0" : "=v"(z_.x)); asm volatile("v_mov_b64 %0, 0" : "=v"(z_.y)); acc[a][b][m][n] = __builtin_bit_cast(f32x4, z_); }
    }
        cur = nxt; cA = nA; cB = nB; ++ui;
        if constexpr (P::GATHER) {
#pragma unroll
            for (int h = 0; h < 2; ++h)
#pragma unroll
                for (int i = 0; i < 2; ++i) vA[h][i] = nvA[h][i]; }
    }
    if (!(CHAIN && chain_out)) {
    PG_WAIT_V(0);
    if (wr == 0) PG_BAR;
    PG_BAR;
    }
#undef PG_SA
#undef PG_SB
#undef PG_STAGE
#undef PG_STAGE_A2
#undef PG_STAGE_B2
#undef PG_LDA
#undef PG_LDB
#undef PG_MMA
#undef PG_MMAZ
#undef PG_WAIT_V
#undef PG_WAIT_L
#undef PG_BAR
#undef PG_SCHED
}
struct ListOrder {
    int nN, first, n;
    __device__ __forceinline__ bool get(int i, int& pm, int& pn) const { if (i >= n) return false; const int L = first + i; pm = L / nN; pn = L % nN; return true; }
};
struct GridOrder {
    int nM, nN, nwg, G, c;
    __device__ __forceinline__ void init(int nM_, int nN_, int G_, int c_) { nM = nM_; nN = nN_; nwg = nM * nN; G = G_; c = c_; }
    __device__ __forceinline__ bool get(int i, int& pm, int& pn) const {
        const long L = (long)i * G + c; if (L >= nwg) return false;
        int wgid = (int)L; { const int q = nwg / 8, r = nwg % 8, xcd = wgid % 8, off = wgid / 8; wgid = (xcd < r ? xcd * (q + 1) : r * (q + 1) + (xcd - r) * q) + off; }
        const int nig = 8 * nN, gid = wgid / nig, fm = gid * 8, gsz = (nM - fm) < 8 ? (nM - fm) : 8;
        pm = fm + ((wgid % nig) % gsz); pn = (wgid % nig) / gsz; return true;
    }
};
}

#ifndef FP8_WO
#define FP8_WO 1
#endif
#ifndef FP8_WOUT
#define FP8_WOUT 1
#endif
constexpr float W13_SCALE = 64.f, W2_SCALE = 32.f;
__device__ __forceinline__ u32x2 pack8_fp8(const f32x4 a, const f32x4 b) { int w0 = 0, w1 = 0; w0 = __builtin_amdgcn_cvt_pk_fp8_f32(a[0], a[1], w0, false); w0 = __builtin_amdgcn_cvt_pk_fp8_f32(a[2], a[3], w0, true);
    w1 = __builtin_amdgcn_cvt_pk_fp8_f32(b[0], b[1], w1, false); w1 = __builtin_amdgcn_cvt_pk_fp8_f32(b[2], b[3], w1, true); return (u32x2){(unsigned)w0, (unsigned)w1}; }
__device__ __forceinline__ void unpack8_fp8(const u32x2 w, f32x4& a, f32x4& b) { const f32x2 a0 = __builtin_amdgcn_cvt_pk_f32_fp8((int)w.x, false), a1 = __builtin_amdgcn_cvt_pk_f32_fp8((int)w.x, true), b0 = __builtin_amdgcn_cvt_pk_f32_fp8((int)w.y, false), b1 = __builtin_amdgcn_cvt_pk_f32_fp8((int)w.y, true);
    a = (f32x4){a0.x, a0.y, a1.x, a1.y}; b = (f32x4){b0.x, b0.y, b1.x, b1.y}; }
struct TrJob { const float* src; size_t sstride; int N, K; bf16* dst; size_t dstride; int nmats, mode, roff; };
__device__ __forceinline__ int tr_drow(int mode, int roff, int n) {
    if (mode == 1) { if (n < 768) return n; if (n < 832) { const int j = n - 768; return 768 + (j < 32 ? 2 * j : 2 * (j - 32) + 1); } return n + 192; }
    if (mode == 2) { const int d = n % 192; if (d < 128) return n; const int j = d - 128; return n - d + 128 + (j < 32 ? 2 * j : 2 * (j - 32) + 1); }
    if (mode == 6) {
        int d = n % 192; const int base = n - d; if (d >= 128) { const int j = d - 128; d = 128 + (j < 32 ? 2 * j : 2 * (j - 32) + 1); }
        const int s = d >> 6, hi = (d >> 5) & 1, b = (d >> 4) & 1, r = d & 15;
        return base + 64 * s + 32 * b + (r & 3) + 8 * (r >> 2) + 4 * hi; }
    if (mode == 3) return (n / 128) * 256 + (n % 128) + roff;
    if (mode == 4) return (n & 128) ? -1 : (n >> 8) * 128 + (n & 127);
    if (mode == 5) return (n & 128) ? (n >> 8) * 128 + (n & 127) : -1;
    return n + roff;
}
struct TrSlab { const float* src; unsigned char* dst; int N, ld, Kd, n0, mode, roff, fmt; };
__device__ __forceinline__ void cossin_d(double r, float& c, float& s) {
    const double r2 = r * r;
    double cs = 1.0, sn = 1.0;
    double tc = 0.0, ts = 0.0;
#pragma unroll
    for (int k = 14; k >= 1; --k) { tc = (1.0 - tc) * r2 / (double)((2 * k - 1) * (2 * k)); ts = (1.0 - ts) * r2 / (double)((2 * k) * (2 * k + 1)); }
    cs = 1.0 - tc; sn = r * (1.0 - ts);
    c = (float)cs; s = (float)sn;
}
constexpr int TR_NJOBS = 15;
constexpr int WIN_SPLIT = 0;
__device__ const int TRT[TR_NJOBS][10] = {
    {I_W1E, DE, DM, DEPTH * NE, 3, 0, 1024, 64, 0, DE}, {I_W3E, DE, DM, DEPTH * NE, 3, 128, 1024, 64, 0, DE}, {I_W2E, DM, DE, DEPTH * NE, 0, 0, DM, 32, 0, DM},
    {I_WIN, NIN, DM, DEPTH, 1, 0, NINP, 0, 0, WIN_SPLIT}, {I_WIN, NIN, DM, DEPTH, 1, 0, NINP, 64, WIN_SPLIT, NIN},
    {I_WUQ, NH * DQK, QL, DEPTH, 6, 0, NH * DQK, 32, 0, NH * DQK}, {I_WUKV, NH * 256, KVL, DEPTH, 4, 0, NH * 128, 0, 0, NH * 256}, {I_WUKV, NH * 256, KVL, DEPTH, 5, 0, NH * 128, 0, 0, NH * 256},
    {I_WOA, DM, DM, DEPTH, 0, 0, DM, FP8_WO ? 64 : 0, 0, DM}, {I_WCO, DM, CW, DEPTH, 0, 0, DM, 0, 0, DM}, {I_WOUT, DM, DM, DEPTH, 0, 0, DM, FP8_WOUT ? 64 : 0, 0, DM},
    {I_W1S, DS, DM, DEPTH, 3, 0, 1024, 64, 0, DS}, {I_W3S, DS, DM, DEPTH, 3, 128, 1024, 64, 0, DS}, {I_WR, NE, DM, DEPTH, 0, 1024, WSR_ROWS, 0, 0, NE}, {I_W2S, DM, DS, DEPTH, 0, 0, DM, 32, 0, DM} };
__device__ const unsigned long long TRO[TR_NJOBS] = {WS_W13E, WS_W13E, WS_W2E, WS_WIN, WS_WIN8, WS_WUQ, WS_WUKV, WS_WUKV + 2 * MiB, FP8_WO ? WS_WO8 : WS_WO, WS_WCO, FP8_WOUT ? WS_WOUT8 : WS_WOUT, WS_WSH8, WS_WSH8, WS_WSR, WS_W2S};
__device__ __forceinline__ void prologue_phase(CArgs& A, LAS unsigned char* lds, int vcu, int G) {
    int tid = threadIdx.x; asm volatile("" : "+v"(tid));
    const int lane = tid & 63, wave = __builtin_amdgcn_readfirstlane(tid >> 6);
    const int gw = vcu * NWAVES + wave, NGW = G * NWAVES;
    unsigned char* ws = A.ws;
    LAS unsigned* scr = (LAS unsigned*)(lds + wave * 8320);
    if (blockIdx.x < DEPTH * (NMOD * DM / 256)) {
        constexpr int NJ = NMOD * DM / 256;
        const int l = blockIdx.x / NJ, jc = blockIdx.x % NJ;
        float* modacc = (float*)(ws + WS_CTL) + CW_MOD;
        const float* w = A.in[I_WADA] + ((size_t)l * DM + wave * 256) * (NMOD * DM) + jc * 256 + lane * 4;
        const float* c0 = A.in[I_C] + wave * 256; const float* c1 = c0 + DM;
        f32x4 a0 = {0.f, 0.f, 0.f, 0.f}, a1 = {0.f, 0.f, 0.f, 0.f};
#pragma unroll 8
        for (int k = 0; k < 256; ++k) { const f32x4 wv = *(const f32x4*)(w + (size_t)k * (NMOD * DM)); const float s0 = siluf_(c0[k]), s1 = siluf_(c1[k]); a0 += wv * s0; a1 += wv * s1; }
        LAS float* part = (LAS float*)(lds + 8 * 8320);
        *(LAS f32x4*)(part + (wave * 2 + 0) * 256 + lane * 4) = a0; *(LAS f32x4*)(part + (wave * 2 + 1) * 256 + lane * 4) = a1;
        __syncthreads();
        { const int b2 = tid >> 8, col = tid & 255; float sum = 0.f;
#pragma unroll
          for (int w8 = 0; w8 < 8; ++w8) sum += part[(w8 * 2 + b2) * 256 + col];
          modacc[((size_t)l * NB + b2) * (NMOD * DM) + jc * 256 + col] = sum + A.in[I_BADA][(size_t)l * (NMOD * DM) + jc * 256 + col]; }
        __syncthreads();
    }
    {
        const int lc = tid & 63, lk = tid >> 6, g4 = lane >> 4, li = lane & 15, lq = li >> 2, lp = li & 3;
        f32x4 v[16];
        TrSlab S; bool have = false;
        unsigned* wqh = (unsigned*)(ws + WS_CTL) + CW_WQ; LAS int* wql = (LAS int*)(lds + LDS_TAB + 128);
        int it;
        if (tid == 0) *wql = (int)atomicAdd(wqh, 1u);
        __syncthreads(); it = *wql;
#define TR_FIND(idx, out, found) do { int r_ = (idx); found = false; \
            for (int j_ = 0; j_ < TR_NJOBS; ++j_) { const int N_ = TRT[j_][1], K_ = TRT[j_][2], nm_ = TRT[j_][3], nb0_ = TRT[j_][8], ne_ = TRT[j_][9]; const int nn_ = (ne_ - nb0_ + 255) >> 8, per_ = nn_ * (K_ >> 7), ns_ = nm_ * per_; \
                if (r_ < ns_) { const int mat_ = r_ / per_, rem_ = r_ % per_, kb_ = rem_ / nn_, nb_ = rem_ % nn_; \
                    (out).N = ne_; (out).ld = N_; (out).Kd = K_; (out).n0 = nb0_ + nb_ * 256; (out).mode = TRT[j_][4]; (out).roff = TRT[j_][5]; \
                    (out).src = A.in[TRT[j_][0]] + (size_t)mat_ * ((size_t)K_ * N_) + (size_t)kb_ * 128 * N_ + nb0_ + nb_ * 256; \
                    (out).fmt = TRT[j_][7]; { const int es_ = TRT[j_][7] ? 1 : 2; (out).dst = ws + TRO[j_] + ((size_t)mat_ * ((size_t)TRT[j_][6] * K_) + kb_ * 128) * es_; } found = true; break; } \
                r_ -= ns_; } } while (0)
#define TR_LOAD(V, SL) do { _Pragma("unroll") for (int j = 0; j < 16; ++j) { const int k = 8 * j + lk; \
            V[j] = ((SL).n0 + 4 * lc < (SL).N) ? *(const f32x4*)((SL).src + (size_t)k * (SL).ld + 4 * lc) : (f32x4){0.f, 0.f, 0.f, 0.f}; } } while (0)
#define TR_STEP(V, SC, haveC) do { if (haveC) { \
            _Pragma("unroll") for (int j = 0; j < 16; ++j) { const int k = 8 * j + lk; u32x2 w; w.x = cvtpk(V[j].x, V[j].y); w.y = cvtpk(V[j].z, V[j].w); \
                *(LAS u32x2*)(lds + k * 544 + ((((lc >> 2) ^ (((k >> 3) & 1) << 2))) << 5) + 8 * (lc & 3)) = w; } \
            if (tid == 0) *wql = (int)atomicAdd(wqh, 1u); \
            __syncthreads(); \
            TrSlab Sn_; bool hn_; { const int it_ = *wql; TR_FIND(it_, Sn_, hn_); } \
            if (hn_) TR_LOAD(V, Sn_); \
            _Pragma("unroll") for (int nbk = 0; nbk < 2; ++nbk) { const int nl0 = (2 * wave + nbk) * 16; const int n = (SC).n0 + nl0 + li; \
                const int dr_ = tr_drow((SC).mode, (SC).roff, n < (SC).N ? n : 0); const bool ok = (n < (SC).N) && dr_ >= 0; \
                unsigned char* drow = (SC).dst + (size_t)(dr_ < 0 ? 0 : dr_) * (SC).Kd * ((SC).fmt ? 1 : 2); \
                _Pragma("unroll") for (int kb = 0; kb < 128; kb += 32) { \
                    const int r0 = kb + 8 * g4 + lq, r1 = r0 + 4; \
                    const int a0 = r0 * 544 + ((((nl0 >> 4) ^ (((r0 >> 3) & 1) << 2))) << 5) + 8 * lp, a1 = r1 * 544 + ((((nl0 >> 4) ^ (((r1 >> 3) & 1) << 2))) << 5) + 8 * lp; \
                    u32x2 x0, x1; \
                    asm volatile("ds_read_b64_tr_b16 %0, %1" : "=&v"(x0) : "v"((int)(uintptr_t)lds + a0) : "memory"); \
                    asm volatile("ds_read_b64_tr_b16 %0, %1" : "=&v"(x1) : "v"((int)(uintptr_t)lds + a1) : "memory"); \
                    asm volatile("s_waitcnt lgkmcnt(0)" ::: "memory"); \
                    if (ok) { if ((SC).fmt == 0) *(u32x4*)(drow + (kb + 8 * g4) * 2) = (u32x4){x0.x, x0.y, x1.x, x1.y}; \
                        else { const float sc_ = (float)(SC).fmt; *(u32x2*)(drow + kb + 8 * g4) = pack8_fp8((f32x4){bflo(x0.x) * sc_, bfhi(x0.x) * sc_, bflo(x0.y) * sc_, bfhi(x0.y) * sc_}, (f32x4){bflo(x1.x) * sc_, bfhi(x1.x) * sc_, bflo(x1.y) * sc_, bfhi(x1.y) * sc_}); } } \
                } } \
            __syncthreads(); \
            SC = Sn_; haveC = hn_; } } while (0)
        f32x4 v2[16]; TrSlab S2; bool have2 = false;
        TR_FIND(it, S, have);
        if (have) TR_LOAD(v, S);
        if (tid == 0) *wql = (int)atomicAdd(wqh, 1u);
        __syncthreads(); { const int it2 = *wql; TR_FIND(it2, S2, have2); }
        if (have2) TR_LOAD(v2, S2);
        __syncthreads();
        while (have || have2) { TR_STEP(v, S, have); TR_STEP(v2, S2, have2); }
#undef TR_STEP
#undef TR_LOAD
#undef TR_FIND
    }
    {
        f32x2* cs = (f32x2*)(ws + WS_CS); const int* pos = (const int*)A.in[I_POS];
        for (int idx = (vcu * NTHREADS + tid); idx < NT * 32; idx += G * NTHREADS) {
            const int t = idx >> 5, i = idx & 31;
            const float ang = (float)pos[t] * inv_freq_tab[i];
            const double ad = (double)ang; const double kk = __builtin_rint(ad * 0.15915494309189533577); const double r = ad - kk * 6.283185307179586476925;
            float c, s; cossin_d(r, c, s); cs[idx] = (f32x2){c, s};
        }
    }
}

struct Row { float v[4][8]; };
__device__ __forceinline__ void row_load_f32(Row& r, const float* p, int lane) {
#pragma unroll
    for (int j = 0; j < 4; ++j) { const f32x4 a = *(const f32x4*)(p + 512 * j + 8 * lane), b = *(const f32x4*)(p + 512 * j + 8 * lane + 4);
        r.v[j][0] = a.x; r.v[j][1] = a.y; r.v[j][2] = a.z; r.v[j][3] = a.w; r.v[j][4] = b.x; r.v[j][5] = b.y; r.v[j][6] = b.z; r.v[j][7] = b.w; }
}
__device__ __forceinline__ void row_store_f32(const Row& r, float* p, int lane) {
#pragma unroll
    for (int j = 0; j < 4; ++j) { *(f32x4*)(p + 512 * j + 8 * lane) = (f32x4){r.v[j][0], r.v[j][1], r.v[j][2], r.v[j][3]}; *(f32x4*)(p + 512 * j + 8 * lane + 4) = (f32x4){r.v[j][4], r.v[j][5], r.v[j][6], r.v[j][7]}; }
}
__device__ __forceinline__ void row_store_bf16(const Row& r, bf16* p, int lane) {
#pragma unroll
    for (int j = 0; j < 4; ++j) { u32x4 o; o.x = cvtpk(r.v[j][0], r.v[j][1]); o.y = cvtpk(r.v[j][2], r.v[j][3]); o.z = cvtpk(r.v[j][4], r.v[j][5]); o.w = cvtpk(r.v[j][6], r.v[j][7]); *(u32x4*)(p + 512 * j + 8 * lane) = o; }
}
__device__ __forceinline__ float row_rstd(const Row& r) {
    float s = 0.f;
#pragma unroll
    for (int j = 0; j < 4; ++j)
#pragma unroll
        for (int q = 0; q < 8; ++q) s += r.v[j][q] * r.v[j][q];
    return rsqrtf(wave_sum(s) * (1.0f / DM) + EPS);
}
struct ModPtr { const float* acc; };
__device__ __forceinline__ ModPtr mod_ptr(CArgs& A, int l, int b, int which) {
    ModPtr m; m.acc = (const float*)(A.ws + WS_CTL) + CW_MOD + ((size_t)l * NB + b) * (NMOD * DM) + which * DM; return m;
}
__device__ __forceinline__ void row_norm_mod_store(const Row& x, const float* g, ModPtr sh, ModPtr sc, bf16* hrow, int lane, unsigned char* h8row = nullptr) {
    const float rstd = row_rstd(x);
    Row o;
#pragma unroll
    for (int j = 0; j < 4; ++j) { const int c0 = 512 * j + 8 * lane;
#pragma unroll
        for (int q4 = 0; q4 < 2; ++q4) { const int c = c0 + 4 * q4;
            const f32x4 gv = *(const f32x4*)(g + c), sa = *(const f32x4*)(sh.acc + c), ca = *(const f32x4*)(sc.acc + c);
#pragma unroll
            for (int q = 0; q < 4; ++q) o.v[j][4 * q4 + q] = (x.v[j][4 * q4 + q] * rstd * gv[q]) * (1.0f + ca[q]) + sa[q]; }
        asm volatile("" ::: "memory"); }
    if (hrow) row_store_bf16(o, hrow, lane);
    if (h8row) {
#pragma unroll
        for (int j = 0; j < 4; ++j) *(u32x2*)(h8row + 512 * j + 8 * lane) = pack8_fp8((f32x4){o.v[j][0], o.v[j][1], o.v[j][2], o.v[j][3]}, (f32x4){o.v[j][4], o.v[j][5], o.v[j][6], o.v[j][7]}); }
}
__device__ __forceinline__ void norm_mod_phase(CArgs& A, const float* xin, const float* g, int l, int wsh, int wsc, int vcu, int G) {
    int tid = threadIdx.x; asm volatile("" : "+v"(tid));
    const int lane = tid & 63, wave = __builtin_amdgcn_readfirstlane(tid >> 6);
    bf16* H = (bf16*)(A.ws + WS_H);
    for (int t = vcu * NWAVES + wave; t < NT; t += G * NWAVES) {
        const int b = t / SEQ; Row x; row_load_f32(x, xin + (size_t)t * DM, lane);
        row_norm_mod_store(x, g, mod_ptr(A, l, b, wsh), mod_ptr(A, l, b, wsc), H + (size_t)t * DM, lane, A.ws + WS_H8 + (size_t)t * DM);
    }
}
__device__ __forceinline__ void postproj_phase(CArgs& A, int l, int vcu, int G) {
    int tid = threadIdx.x; asm volatile("" : "+v"(tid));
    const int lane = tid & 63, wave = __builtin_amdgcn_readfirstlane(tid >> 6);
    const bf16* P = (const bf16*)(A.ws + WS_PROJ);
    bf16* CQN = (bf16*)(A.ws + WS_CQN); bf16* CKVN = (bf16*)(A.ws + WS_CKVN); bf16* CZ = (bf16*)(A.ws + WS_CZ); unsigned char* Kb = A.ws + WS_K;
    const f32x2* cs = (const f32x2*)(A.ws + WS_CS);
    const float* gq = A.in[I_GQ] + l * QL; const float* gkv = A.in[I_GKV] + l * KVL; const float* cw = A.in[I_CONVW] + (size_t)l * 3 * CW;
    for (int t = vcu * NWAVES + wave; t < NT; t += G * NWAVES) {
        const int b = t / SEQ, s = t % SEQ; const bf16* pr = P + (size_t)t * NINP;
        {
            const u32x4 w = *(const u32x4*)(pr + PC_CQ + 8 * lane); float v[8] = {bflo(w.x), bfhi(w.x), bflo(w.y), bfhi(w.y), bflo(w.z), bfhi(w.z), bflo(w.w), bfhi(w.w)};
            float ss = 0.f;
#pragma unroll
            for (int q = 0; q < 8; ++q) ss += v[q] * v[q];
            const float rstd = rsqrtf(wave_sum(ss) * (1.0f / QL) + EPS);
            const f32x4 g0 = *(const f32x4*)(gq + 8 * lane), g1 = *(const f32x4*)(gq + 8 * lane + 4);
            u32x4 o; o.x = cvtpk(v[0] * rstd * g0.x, v[1] * rstd * g0.y); o.y = cvtpk(v[2] * rstd * g0.z, v[3] * rstd * g0.w); o.z = cvtpk(v[4] * rstd * g1.x, v[5] * rstd * g1.y); o.w = cvtpk(v[6] * rstd * g1.z, v[7] * rstd * g1.w);
            *(u32x2*)((unsigned char*)CQN + (size_t)t * QL + 8 * lane) = pack8_fp8((f32x4){v[0] * rstd * g0.x, v[1] * rstd * g0.y, v[2] * rstd * g0.z, v[3] * rstd * g0.w}, (f32x4){v[4] * rstd * g1.x, v[5] * rstd * g1.y, v[6] * rstd * g1.z, v[7] * rstd * g1.w});
        }
        {
            const u32x2 w = *(const u32x2*)(pr + PC_CKV + 4 * lane); float v[4] = {bflo(w.x), bfhi(w.x), bflo(w.y), bfhi(w.y)};
            const float rstd = rsqrtf(wave_sum(v[0] * v[0] + v[1] * v[1] + v[2] * v[2] + v[3] * v[3]) * (1.0f / KVL) + EPS);
            const f32x4 g0 = *(const f32x4*)(gkv + 4 * lane);
            u32x2 o; o.x = cvtpk(v[0] * rstd * g0.x, v[1] * rstd * g0.y); o.y = cvtpk(v[2] * rstd * g0.z, v[3] * rstd * g0.w);
            *(u32x2*)(CKVN + (size_t)t * KVL + 4 * lane) = o;
        }
        {
            const float v = __uint_as_float((unsigned)pr[PC_KPE + lane] << 16); const float o = __shfl_xor(v, 1);
            const f32x2 c = cs[t * 32 + (lane >> 1)];
            const float r = ((lane & 1) ? (v * c.x + o * c.y) : (v * c.x - o * c.y)) * 0.25f;
            const unsigned char rb = (unsigned char)(__builtin_amdgcn_cvt_pk_fp8_f32(r, r, 0, false) & 0xff);
            unsigned char* kd = Kb + ((size_t)(b * NH) * SEQ + s) * DQK + DNOPE + lane;
#pragma unroll
            for (int h = 0; h < NH; ++h) kd[(size_t)h * SEQ * DQK] = rb;
        }
        {
            const int c0 = 16 * lane;
            float z[3][16];
#pragma unroll
            for (int d = 0; d < 3; ++d) {
                const int ss = s + d - 1; const bool ok = (ss >= 0 && ss < SEQ);
                const bf16* p2 = pr + (ptrdiff_t)(d - 1) * NINP;
                u32x4 gc0 = {0, 0, 0, 0}, gc1 = gc0, u0 = gc0, u1 = gc0;
                if (ok) { gc0 = *(const u32x4*)(p2 + PC_GC + c0); gc1 = *(const u32x4*)(p2 + PC_GC + c0 + 8); u0 = *(const u32x4*)(p2 + PC_U + c0); u1 = *(const u32x4*)(p2 + PC_U + c0 + 8); }
                const unsigned gw_[8] = {gc0.x, gc0.y, gc0.z, gc0.w, gc1.x, gc1.y, gc1.z, gc1.w}, uw_[8] = {u0.x, u0.y, u0.z, u0.w, u1.x, u1.y, u1.z, u1.w};
#pragma unroll
                for (int q = 0; q < 8; ++q) { z[d][2 * q] = bflo(gw_[q]) * bflo(uw_[q]); z[d][2 * q + 1] = bfhi(gw_[q]) * bfhi(uw_[q]); }
            }
            const u32x4 gb0 = *(const u32x4*)(pr + PC_GB + c0), gb1 = *(const u32x4*)(pr + PC_GB + c0 + 8);
            const unsigned gbw[8] = {gb0.x, gb0.y, gb0.z, gb0.w, gb1.x, gb1.y, gb1.z, gb1.w};
            float o[16];
#pragma unroll
            for (int q4 = 0; q4 < 4; ++q4) { const f32x4 w0 = *(const f32x4*)(cw + c0 + 4 * q4), w1 = *(const f32x4*)(cw + CW + c0 + 4 * q4), w2 = *(const f32x4*)(cw + 2 * CW + c0 + 4 * q4);
#pragma unroll
                for (int q = 0; q < 4; ++q) { const int i = 4 * q4 + q; const float gbv = (i & 1) ? bfhi(gbw[i >> 1]) : bflo(gbw[i >> 1]); o[i] = gbv * (w0[q] * z[0][i] + w1[q] * z[1][i] + w2[q] * z[2][i]); } }
            u32x4 o0, o1; o0.x = cvtpk(o[0], o[1]); o0.y = cvtpk(o[2], o[3]); o0.z = cvtpk(o[4], o[5]); o0.w = cvtpk(o[6], o[7]); o1.x = cvtpk(o[8], o[9]); o1.y = cvtpk(o[10], o[11]); o1.z = cvtpk(o[12], o[13]); o1.w = cvtpk(o[14], o[15]);
            *(u32x4*)(CZ + (size_t)t * CW + c0) = o0; *(u32x4*)(CZ + (size_t)t * CW + c0 + 8) = o1;
        }
    }
}
__device__ __forceinline__ void nmr_phase(CArgs& A, const float* xin, int l, int vcu, LAS unsigned char* lds) {
    int tid = threadIdx.x; asm volatile("" : "+v"(tid));
    const int lane = tid & 63, wave = __builtin_amdgcn_readfirstlane(tid >> 6);
    bf16* H = (bf16*)(A.ws + WS_H); int* LIST = (int*)(A.ws + WS_LIST);
    unsigned* ASG = (unsigned*)(A.ws + WS_ASG); float* ASGW = (float*)(A.ws + WS_ASG + 512 * 1024);
    unsigned* cnt = (unsigned*)(A.ws + WS_CTL) + CW_CNT + l * 64;
    const int t0 = vcu * 32;
    {
        const float* g = A.in[I_GFFN] + (size_t)l * DM;
        for (int r = 0; r < 4; ++r) { const int t = t0 + wave * 4 + r; const int b = t / SEQ; Row x; row_load_f32(x, xin + (size_t)t * DM, lane);
            row_norm_mod_store(x, g, mod_ptr(A, l, b, 3), mod_ptr(A, l, b, 4), H + (size_t)t * DM, lane, A.ws + WS_H8 + (size_t)t * DM); }
    }
    asm volatile("s_waitcnt vmcnt(0)" ::: "memory"); __syncthreads();
    {
        const int r32 = lane & 31, hi = lane >> 5, k0 = wave * 256 + 8 * hi;
        const bf16* WR = (const bf16*)(A.ws + WS_WSR) + ((size_t)l * WSR_ROWS + 1024) * DM;
        const bf16* hp = H + (size_t)(t0 + r32) * DM + k0; const bf16* w0 = WR + (size_t)r32 * DM + k0; const bf16* w1 = w0 + (size_t)32 * DM;
        f32x16 acc0 = {}, acc1 = {};
#pragma unroll 4
        for (int s = 0; s < 16; ++s) { const bf16x8 hb = *(const bf16x8*)(hp + 16 * s), a0 = *(const bf16x8*)(w0 + 16 * s), a1 = *(const bf16x8*)(w1 + 16 * s);
            acc0 = __builtin_amdgcn_mfma_f32_32x32x16_bf16(a0, hb, acc0, 0, 0, 0); acc1 = __builtin_amdgcn_mfma_f32_32x32x16_bf16(a1, hb, acc1, 0, 0, 0); }
        LAS float* part = (LAS float*)lds + (size_t)(wave * 32 + r32) * 64;
#pragma unroll
        for (int r = 0; r < 16; ++r) { const int e = (r & 3) + 8 * (r >> 2) + 4 * hi; part[e] = acc0[r]; part[32 + e] = acc1[r]; }
    }
    __syncthreads();
    const float br = A.in[I_BR][l * NE + lane];
    for (int r = 0; r < 4; ++r) {
        const int tl = wave * 4 + r, t = t0 + tl;
        float lg = 0.f;
#pragma unroll
        for (int w8 = 0; w8 < 8; ++w8) lg += ((LAS float*)lds)[(size_t)(w8 * 32 + tl) * 64 + lane];
        const float score = 1.0f / (1.0f + expf(-lg)); const float biased = score + br;
        float m1 = biased; int i1 = lane;
#pragma unroll
        for (int o = 1; o < 8; o <<= 1) { const float ov = __shfl_xor(m1, o); const int oi = __shfl_xor(i1, o); if (ov > m1 || (ov == m1 && oi < i1)) { m1 = ov; i1 = oi; } }
        float m2 = (lane == i1) ? -INFINITY : biased;
#pragma unroll
        for (int o = 1; o < 8; o <<= 1) m2 = fmaxf(m2, __shfl_xor(m2, o));
        const float gs = m1 + m2; const int grp = lane >> 3;
        int grank = 0;
#pragma unroll
        for (int g2 = 0; g2 < 8; ++g2) { const float og = readlane_f(gs, g2 * 8); grank += (og > gs || (og == gs && g2 < grp)) ? 1 : 0; }
        const bool allowed = grank < 4;
        const float mv = allowed ? biased : -INFINITY;
        int rank = 0;
#pragma unroll
        for (int e2 = 0; e2 < 64; ++e2) { const float ov = readlane_f(mv, e2); rank += (ov > mv || (ov == mv && e2 < lane)) ? 1 : 0; }
        const bool sel = allowed && rank < TOPK;
        const float ssum = wave_sum(sel ? score : 0.f);
        if (sel) {
            const unsigned slot = atomicAdd(cnt + lane, 1u);
            LIST[lane * NT + slot] = t; ASG[(size_t)t * 8 + rank] = ((unsigned)lane << 16) | slot; ASGW[(size_t)t * 8 + rank] = score / ssum * 2.5f;
        }
    }
    __syncthreads();
}

template <int K_, class Epi, class Ord = pg::GridOrder, bool FP8_ = false> struct DenseP {
    static constexpr int K = K_, LDA = K_, LDB = K_, ES = FP8_ ? 1 : 2; static constexpr bool PERM = Epi::PERM, GATHER = false, HALF = false, FP8 = FP8_; static constexpr int BMODE = pg::bmode_of<Epi>::value;
    const char* A; const char* Bt; Ord ord; Epi e;
    __device__ __forceinline__ bool next(int i, pg::Unit& u) const { u.aux = 0; u.aux2 = 0; u.half = 0; return ord.get(i, u.pm, u.pn); }
    __device__ __forceinline__ const char* a_base(const pg::Unit& u) const { return A + (size_t)u.pm * 256 * K * ES; }
    __device__ __forceinline__ const char* b_base(const pg::Unit& u) const { return Bt + (size_t)u.pn * 256 * K * ES; }
    __device__ __forceinline__ void a_offsets(const pg::Unit&, unsigned (&)[2][2]) const {}
    __device__ __forceinline__ void epi(const pg::Acc& acc, const pg::Unit& u, int wr, int wc, int fr, int fq) const { e(acc, u, wr, wc, fr, fq); }
};
template <class Epi, int K_ = DM, class Ord = pg::GridOrder> struct WinP {
    static constexpr int K = K_, LDA = K_, LDB = K_; static constexpr bool PERM = Epi::PERM, GATHER = true, HALF = false, FP8 = true;
    const char* A; const char* Bt; Ord ord; Epi e;
    __device__ __forceinline__ bool next(int i, pg::Unit& u) const { u.aux = 0; u.aux2 = 0; u.half = 0; return ord.get(i, u.pm, u.pn); }
    __device__ __forceinline__ const char* a_base(const pg::Unit&) const { return A; }
    __device__ __forceinline__ const char* b_base(const pg::Unit& u) const { return Bt + (size_t)u.pn * 256 * K; }
    __device__ __forceinline__ void a_offsets(const pg::Unit& u, unsigned (&off)[2][2]) const {
        int R[2], C[2]; { const int t_ = otid(); pg::stage_rc(t_ * 16, R[0], C[0]); pg::stage_rc(t_ * 16 + 8192, R[1], C[1]); }
#pragma unroll
        for (int h = 0; h < 2; ++h)
#pragma unroll
            for (int i = 0; i < 2; ++i) off[h][i] = (unsigned)((u.pm * 256 + R[i] + 128 * h) * K + C[i] * 2);
    }
    __device__ __forceinline__ void epi(const pg::Acc& acc, const pg::Unit& u, int wr, int wc, int fr, int fq) const { e(acc, u, wr, wc, fr, fq); }
};
#define EPI_ROWS_BEGIN _Pragma("unroll") for (int ai = 0; ai < 2; ++ai) _Pragma("unroll") for (int m = 0; m < 4; ++m) { const int rl = ai * 128 + wr * 64 + m * 16 + fr; const int row = u.pm * 256 + rl; (void)row;
#define EPI_ROWS_END }
__device__ __forceinline__ u32x4 pack8(const f32x4 a, const f32x4 b) { u32x4 w; w.x = cvtpk(a[0], a[1]); w.y = cvtpk(a[2], a[3]); w.z = cvtpk(b[0], b[1]); w.w = cvtpk(b[2], b[3]); return w; }
__device__ __forceinline__ void unpack8(const u32x4 w, f32x4& a, f32x4& b) { a = (f32x4){bflo(w.x), bfhi(w.x), bflo(w.y), bfhi(w.y)}; b = (f32x4){bflo(w.z), bfhi(w.z), bflo(w.w), bfhi(w.w)}; }
struct EpiProj { static constexpr bool PERM = true; bf16* P; float isc; int pn0;
    __device__ __forceinline__ void operator()(const pg::Acc& acc, const pg::Unit& u, int wr, int wc, int fr, int fq) const {
        const int pn = u.pn + pn0; const bool sg = pn >= PC_LA / 256;
        EPI_ROWS_BEGIN
#pragma unroll
            for (int bj = 0; bj < 2; ++bj) { f32x4 v0 = acc[ai][bj][m][0] * isc, v1 = acc[ai][bj][m][1] * isc;
                if (sg) {
#pragma unroll
                    for (int q = 0; q < 4; ++q) { v0[q] = sigmoidf_(v0[q]); v1[q] = sigmoidf_(v1[q]); } }
                *(u32x4*)(P + (size_t)row * NINP + pn * 256 + bj * 128 + wc * 32 + 8 * fq) = pack8(v0, v1); }
        EPI_ROWS_END
    } };
#define EPI_G(g) const int ai = (g) >> 2, m = (g) & 3; const int rl = ai * 128 + wr * 64 + m * 16 + fr; const int row = u.pm * 256 + rl; (void)row; (void)ai; (void)m;
template <class E> __device__ __forceinline__ void epi_pipelined(const E& e, const pg::Acc& acc, const pg::Unit& u, int wr, int wc, int fr, int fq) {
    typename E::Regs r0, r1;
    e.load(r0, u, 0, wr, wc, fr, fq);
#pragma unroll
    for (int g = 0; g < 8; g += 2) {
        e.load(r1, u, g + 1, wr, wc, fr, fq);
        asm volatile("" ::: "memory");
        e.finish(r0, acc, u, g, wr, wc, fr, fq);
        asm volatile("" ::: "memory");
        if (g + 2 < 8) e.load(r0, u, g + 2, wr, wc, fr, fq);
        asm volatile("" ::: "memory");
        e.finish(r1, acc, u, g + 1, wr, wc, fr, fq);
        asm volatile("" ::: "memory");
    }
}
constexpr float QSCALE = 0.07216878364870322f * 1.4426950408889634f * 4.0f, KSCALE = 0.25f;
struct EpiQ { static constexpr bool PERM = true; unsigned char* Q; const f32x2* cs;
    struct Regs { f32x2 c[2][4]; };
    __device__ __forceinline__ void load(Regs& r, const pg::Unit& u, int g, int wr, int wc, int fr, int fq) const {
        EPI_G(g)
#pragma unroll
        for (int bj = 0; bj < 2; ++bj) { const int col = u.pn * 256 + bj * 128 + wc * 32 + 8 * fq; const int d = col % DQK;
            if (d >= DNOPE) { const f32x2* c = cs + (size_t)row * 32 + ((d - DNOPE) >> 1); r.c[bj][0] = c[0]; r.c[bj][1] = c[1]; r.c[bj][2] = c[2]; r.c[bj][3] = c[3]; } }
    }
    __device__ __forceinline__ void finish(const Regs& r, const pg::Acc& acc, const pg::Unit& u, int g, int wr, int wc, int fr, int fq) const {
        constexpr float SC = (1.0f / W2_SCALE) * QSCALE;
        EPI_G(g)
        const int b = row / SEQ, s = row % SEQ;
#pragma unroll
        for (int bj = 0; bj < 2; ++bj) { const int col = u.pn * 256 + bj * 128 + wc * 32 + 8 * fq; const int head = col / DQK, d = col % DQK;
            f32x4 v0 = acc[ai][bj][m][0] * SC, v1 = acc[ai][bj][m][1] * SC;
            if (d >= DNOPE) { const f32x2 c0 = r.c[bj][0], c1 = r.c[bj][1], c2 = r.c[bj][2], c3 = r.c[bj][3];
                const f32x4 r0 = {v0[0] * c0.x - v0[1] * c0.y, v0[1] * c0.x + v0[0] * c0.y, v0[2] * c1.x - v0[3] * c1.y, v0[3] * c1.x + v0[2] * c1.y};
                const f32x4 r1 = {v1[0] * c2.x - v1[1] * c2.y, v1[1] * c2.x + v1[0] * c2.y, v1[2] * c3.x - v1[3] * c3.y, v1[3] * c3.x + v1[2] * c3.y};
                v0 = r0; v1 = r1; }
            *(u32x2*)(Q + ((size_t)(b * NH + head) * SEQ + s) * DQK + d) = pack8_fp8(v0, v1); }
    }
    __device__ __forceinline__ void operator()(const pg::Acc& acc, const pg::Unit& u, int wr, int wc, int fr, int fq) const { epi_pipelined(*this, acc, u, wr, wc, fr, fq); }
};
struct EpiK { static constexpr bool PERM = true; static constexpr int BMODE = 1; unsigned char* Kb;
    __device__ __forceinline__ void operator()(const pg::Acc& acc, const pg::Unit& u, int wr, int wc, int fr, int fq) const {
        EPI_ROWS_BEGIN
            const int b = row / SEQ, s = row % SEQ;
            const u32x2 lo = pack8_fp8(acc[ai][0][m][0] * KSCALE, acc[ai][0][m][1] * KSCALE), hi2 = pack8_fp8(acc[ai][1][m][0] * KSCALE, acc[ai][1][m][1] * KSCALE);
            *(u32x4*)(Kb + ((size_t)(b * NH + u.pn * 2 + (wc >> 1)) * SEQ + s) * DQK + (wc & 1) * 64 + 16 * fq) = (u32x4){lo.x, lo.y, hi2.x, hi2.y};
        EPI_ROWS_END
    } };
struct EpiVt { static constexpr bool PERM = true; static constexpr int BMODE = 2; unsigned char* Vt;
    __device__ __forceinline__ void operator()(const pg::Acc& acc, const pg::Unit& u, int wr, int wc, int fr, int fq) const {
        const int t0 = u.pn * 256 + 64 * wc; const int b = t0 / SEQ, s0 = t0 % SEQ; const int pos = s0 + 32 * (fq & 1) + 16 * (fq >> 1);
        EPI_ROWS_BEGIN
            const int h = row >> 7, d = row & 127;
            u32x4 w4;
#pragma unroll
            for (int c = 0; c < 4; ++c) { const int bj = c >> 1, n = c & 1; int w = 0;
                w = __builtin_amdgcn_cvt_pk_fp8_f32(acc[ai][bj][m][n][0], acc[ai][bj][m][n][1], w, false); w = __builtin_amdgcn_cvt_pk_fp8_f32(acc[ai][bj][m][n][2], acc[ai][bj][m][n][3], w, true); w4[c] = (unsigned)w; }
            *(u32x4*)(Vt + ((size_t)((b * NH + h) * DV + d)) * SEQ + pos) = w4;
        EPI_ROWS_END
    } };
struct EpiConv { static constexpr bool PERM = true; const bf16* P; bf16* M1;
    struct Regs { u32x4 p[2]; };
    __device__ __forceinline__ void load(Regs& r, const pg::Unit& u, int g, int wr, int wc, int fr, int fq) const {
        EPI_G(g)
#pragma unroll
        for (int bj = 0; bj < 2; ++bj) r.p[bj] = *(const u32x4*)(P + (size_t)row * NINP + PC_LC + u.pn * 256 + bj * 128 + wc * 32 + 8 * fq);
    }
    __device__ __forceinline__ void finish(const Regs& r, const pg::Acc& acc, const pg::Unit& u, int g, int wr, int wc, int fr, int fq) const {
        EPI_G(g)
#pragma unroll
        for (int bj = 0; bj < 2; ++bj) { const int col = u.pn * 256 + bj * 128 + wc * 32 + 8 * fq; f32x4 g0, g1; unpack8(r.p[bj], g0, g1);
            *(u32x4*)(M1 + (size_t)row * DM + col) = pack8(acc[ai][bj][m][0] * g0, acc[ai][bj][m][1] * g1); }
    }
    __device__ __forceinline__ void operator()(const pg::Acc& acc, const pg::Unit& u, int wr, int wc, int fr, int fq) const { epi_pipelined(*this, acc, u, wr, wc, fr, fq); }
};
struct EpiWo { static constexpr bool PERM = true; const bf16* P; const bf16* M1; bf16* MIX; unsigned char* MIX8; float isc;
    struct Regs { u32x4 p[2], q[2]; };
    __device__ __forceinline__ void load(Regs& r, const pg::Unit& u, int g, int wr, int wc, int fr, int fq) const {
        EPI_G(g)
#pragma unroll
        for (int bj = 0; bj < 2; ++bj) { const int col = u.pn * 256 + bj * 128 + wc * 32 + 8 * fq; r.p[bj] = *(const u32x4*)(P + (size_t)row * NINP + PC_LA + col); r.q[bj] = *(const u32x4*)(M1 + (size_t)row * DM + col); }
    }
    __device__ __forceinline__ void finish(const Regs& r, const pg::Acc& acc, const pg::Unit& u, int g, int wr, int wc, int fr, int fq) const {
        EPI_G(g)
#pragma unroll
        for (int bj = 0; bj < 2; ++bj) { const int col = u.pn * 256 + bj * 128 + wc * 32 + 8 * fq; f32x4 g0, g1, a0, a1; unpack8(r.p[bj], g0, g1); unpack8(r.q[bj], a0, a1);
            const f32x4 m0 = acc[ai][bj][m][0] * isc * g0 + a0, m1v = acc[ai][bj][m][1] * isc * g1 + a1;
            if (FP8_WOUT) *(u32x2*)(MIX8 + (size_t)row * DM + col) = pack8_fp8(m0, m1v); else *(u32x4*)(MIX + (size_t)row * DM + col) = pack8(m0, m1v); }
    }
    __device__ __forceinline__ void operator()(const pg::Acc& acc, const pg::Unit& u, int wr, int wc, int fr, int fq) const { epi_pipelined(*this, acc, u, wr, wc, fr, fq); }
};
struct EpiWout { static constexpr bool PERM = false; const float* xin; float* xout; const float* gacc; float isc;
    struct Regs { f32x4 x[2][2]; };
    __device__ __forceinline__ void load(Regs& r, const pg::Unit& u, int g, int wr, int wc, int fr, int fq) const {
        EPI_G(g)
#pragma unroll
        for (int bj = 0; bj < 2; ++bj)
#pragma unroll
            for (int n = 0; n < 2; ++n) r.x[bj][n] = *(const f32x4*)(xin + (size_t)row * DM + u.pn * 256 + bj * 128 + wc * 32 + 16 * n + 4 * fq);
    }
    __device__ __forceinline__ void finish(const Regs& r, const pg::Acc& acc, const pg::Unit& u, int g, int wr, int wc, int fr, int fq) const {
        EPI_G(g)
        const int b = (u.pm * 256) / SEQ;
#pragma unroll
        for (int bj = 0; bj < 2; ++bj)
#pragma unroll
            for (int n = 0; n < 2; ++n) { const int col = u.pn * 256 + bj * 128 + wc * 32 + 16 * n + 4 * fq;
                const f32x4 gv = *(const f32x4*)(gacc + (size_t)b * (NMOD * DM) + col);
                *(f32x4*)(xout + (size_t)row * DM + col) = r.x[bj][n] + gv * (acc[ai][bj][m][n] * isc); }
    }
    __device__ __forceinline__ void operator()(const pg::Acc& acc, const pg::Unit& u, int wr, int wc, int fr, int fq) const { epi_pipelined(*this, acc, u, wr, wc, fr, fq); }
};
struct MoeTab { LAS int* cnt; LAS int* ts; LAS int* ord; };
__device__ __forceinline__ int wave_incl_scan(int v, int lane) {
#pragma unroll
    for (int o = 1; o < 64; o <<= 1) { const int u = __shfl_up(v, o); v += (lane >= o) ? u : 0; }
    return v;
}
__device__ __forceinline__ MoeTab moe_tables(CArgs& A, int l, LAS unsigned char* lds, bool want_order) {
    MoeTab T; T.cnt = (LAS int*)(lds + LDS_TAB + 256); T.ts = T.cnt + 64; T.ord = (LAS int*)(lds + LDS_TAB + 1024) + 1;
    unsigned* cg = (unsigned*)(A.ws + WS_CTL) + CW_CNT + l * 64;
    const int tt = otid();
    __syncthreads();
    if (tt < 64) {
        const int e = tt; const int c = (int)__hip_atomic_load(cg + e, RLX_AGENT);
        T.cnt[e] = c;
        const int nall = (c + 255) >> 8; const int ia = wave_incl_scan(nall, e);
        T.ts[e] = ia - nall; if (e == 63) T.ts[64] = ia;
        if (want_order) {
            const int nfull = c >> 8, rem = c & 255;
            const int n1 = nfull + (rem > 128 ? 1 : 0), nh = (rem != 0 && rem <= 128) ? 1 : 0;
            const int p1 = wave_incl_scan(n1, e), ph = wave_incl_scan(nh, e);
            const int tot1 = __builtin_amdgcn_readlane(p1, 63), toth = __builtin_amdgcn_readlane(ph, 63);
            if (e < NT / 256) T.ord[e] = 64 | (e << 8);
            const int pos = NT / 256 + p1 - n1;
#pragma nounroll
            for (int m = 0; m < n1; ++m) T.ord[pos + m] = e | (m << 8);
            if (nh) T.ord[NT / 256 + tot1 + ph - 1] = e | (nfull << 8) | (1 << 16);
            if (e == 0) T.ord[-1] = NT / 256 + tot1 + toth;
        }
    }
    __syncthreads();
    return T;
}
struct Moe1P {
    static constexpr int K = DM, LDA = DM, LDB = DM; static constexpr bool PERM = true, GATHER = true, HALF = true, FP8 = true, PEEL = true;
    const char* H; const char* W; const char* WSH; const int* LIST; bf16* ACT; bf16* SACT; MoeTab T; int G, c;
    __device__ __forceinline__ bool next(int i, pg::Unit& u) const {
        const int L = i * 256 + (c & 7) * 32 + (c >> 3); const int ti = L >> 2;
        if (ti >= T.ord[-1]) return false;
        const int en = T.ord[ti]; const int e = en & 255, mt = (en >> 8) & 255;
        u.pn = L & 3; u.pm = mt; u.aux = e; u.half = en >> 16; u.aux2 = (e < 64 ? T.ts[e] + mt : mt) * 256;
        return true;
    }
    __device__ __forceinline__ const char* a_base(const pg::Unit&) const { return H; }
    __device__ __forceinline__ const char* b_base(const pg::Unit& u) const { return u.aux < 64 ? W + ((size_t)u.aux * 1024 + (size_t)u.pn * 256) * K : WSH + (size_t)u.pn * 256 * K; }
    __device__ __forceinline__ void a_offsets(const pg::Unit& u, unsigned (&off)[2][2]) const {
        int R[2], C[2]; { const int t_ = otid(); pg::stage_rc(t_ * 16, R[0], C[0]); pg::stage_rc(t_ * 16 + 8192, R[1], C[1]); }
        if (u.aux < 64) {
            const int n = T.cnt[u.aux]; const int* lp = LIST + (size_t)u.aux * NT + u.pm * 256;
#pragma unroll
            for (int h = 0; h < 2; ++h)
#pragma unroll
                for (int i = 0; i < 2; ++i) { const int r = R[i] + 128 * h; const int tok = (u.pm * 256 + r < n) ? lp[r] : 0; off[h][i] = (unsigned)(tok * K + C[i] * 2); }
        } else {
#pragma unroll
            for (int h = 0; h < 2; ++h)
#pragma unroll
                for (int i = 0; i < 2; ++i) off[h][i] = (unsigned)((u.pm * 256 + R[i] + 128 * h) * K + C[i] * 2);
        }
    }
    __device__ __forceinline__ void epi(const pg::Acc& acc, const pg::Unit& u, int wr, int wc, int fr, int fq) const {
        bf16* D = u.aux < 64 ? ACT : SACT;
        EPI_ROWS_BEGIN
            if (ai == 1 && u.half) continue;
            f32x4 v0, v1;
#pragma unroll
            for (int q = 0; q < 4; ++q) { constexpr float IS = 1.0f / W13_SCALE; v0[q] = siluf_(acc[ai][0][m][0][q] * IS) * (acc[ai][1][m][0][q] * IS); v1[q] = siluf_(acc[ai][0][m][1][q] * IS) * (acc[ai][1][m][1][q] * IS); }
            *(u32x2*)((unsigned char*)D + (size_t)(u.aux2 + rl) * DE + u.pn * 128 + wc * 32 + 8 * fq) = pack8_fp8(v0, v1);
        EPI_ROWS_END
    }
};
struct Moe2P {
    static constexpr int K = DE, LDA = DE, LDB = DE; static constexpr bool PERM = true, GATHER = false, HALF = true, FP8 = true, PEEL = true; static constexpr int BMODE = 1;
    const char* ACT; const char* SACT; const char* W; const char* WS2; bf16* OUT2; MoeTab T; int G, c;
    __device__ __forceinline__ bool next(int i, pg::Unit& u) const {
        const int L = i * 256 + (c & 7) * 32 + (c >> 3); const int ti = L >> 3;
        if (ti >= T.ord[-1]) return false;
        const int en = T.ord[ti]; const int e = en & 255, mt = (en >> 8) & 255;
        u.pn = L & 7; u.aux = e; u.half = en >> 16;
        if (e < 64) { u.pm = T.ts[e] + mt; u.aux2 = u.pm * 256; } else { u.pm = mt; u.aux2 = MAXROWS + mt * 256; }
        return true;
    }
    __device__ __forceinline__ const char* a_base(const pg::Unit& u) const { return u.aux < 64 ? ACT + (size_t)u.pm * 256 * K : SACT + (size_t)u.pm * 256 * K; }
    __device__ __forceinline__ const char* b_base(const pg::Unit& u) const { return u.aux < 64 ? W + ((size_t)u.aux * DM + (size_t)u.pn * 256) * K : WS2 + (size_t)u.pn * 256 * K; }
    __device__ __forceinline__ void a_offsets(const pg::Unit&, unsigned (&)[2][2]) const {}
    __device__ __forceinline__ void epi(const pg::Acc& acc, const pg::Unit& u, int wr, int wc, int fr, int fq) const {
        EPI_ROWS_BEGIN
            if (ai == 1 && u.half) continue;
            { const u32x2 lo = pack8_fp8(acc[ai][0][m][0] * (1.0f / W2_SCALE), acc[ai][0][m][1] * (1.0f / W2_SCALE)), hi2 = pack8_fp8(acc[ai][1][m][0] * (1.0f / W2_SCALE), acc[ai][1][m][1] * (1.0f / W2_SCALE));
              *(u32x4*)((unsigned char*)OUT2 + (size_t)(u.aux2 + rl) * DM + u.pn * 256 + wc * 64 + 16 * fq) = (u32x4){lo.x, lo.y, hi2.x, hi2.y}; }
        EPI_ROWS_END
    }
};

namespace att {
typedef int v8i __attribute__((ext_vector_type(8))); typedef int v4i __attribute__((ext_vector_type(4)));
constexpr int NW = 8, QBLK = 32, KVBLK = 64;
constexpr int SHM_V = KVBLK * DV, SHM_K = KVBLK * DQK;
constexpr int SHM_ATTN = 128 * 1024;
#ifndef ATT_SDEPTH
#define ATT_SDEPTH 1
#endif
constexpr int SDEPTH = ATT_SDEPTH;
constexpr float THR = 5.f;
#define KSWZ(row, colB) ((row) * (DQK * 2) + ((colB) ^ ((((row) >> 1) & 7) << 4)))
#define SBAR() __builtin_amdgcn_sched_barrier(0)
__device__ __forceinline__ int crow(int r, int hi) { return (r & 3) + 8 * (r >> 2) + 4 * hi; }
constexpr float THR2 = 5.f * 1.4426950408889634f;
template <bool FIRST>
__device__ __forceinline__ void partialSM(f32x16& p0, f32x16& p1, float& m_reg, f32x16& nm16, float& alpha) {
  float pmax = p0[0];
#pragma unroll
  for (int r = 1; r < 16; ++r) pmax = fmaxf(pmax, p0[r]);
#pragma unroll
  for (int r = 0; r < 16; ++r) pmax = fmaxf(pmax, p1[r]);
  { auto rr = __builtin_amdgcn_permlane32_swap(__float_as_uint(pmax), __float_as_uint(pmax), false, false);
    pmax = fmaxf(__uint_as_float(rr[0]), __uint_as_float(rr[1])); }
  if (!FIRST && __builtin_expect(__all(pmax <= THR2), 1)) { alpha = 1.f; }
  else { const float d = FIRST ? pmax : fmaxf(pmax, 0.f);
    alpha = FIRST ? 1.f : __builtin_amdgcn_exp2f(-d); m_reg += d;
    const float nm = -m_reg;
#pragma unroll
    for (int r = 0; r < 16; ++r) { p0[r] -= d; p1[r] -= d; float t = nm16[r]; asm volatile("v_mov_b32 %0, %1" : "+v"(t) : "v"(nm)); nm16[r] = t; } }
#pragma unroll
  for (int r = 0; r < 16; ++r) p0[r] = __builtin_amdgcn_exp2f(p0[r]);
}
__device__ __forceinline__ void finishSM(f32x16& p0, f32x16& p1, float alpha, float& l_reg, v8i& pa) {
#pragma unroll
  for (int r = 0; r < 16; ++r) p1[r] = __builtin_amdgcn_exp2f(p1[r]);
  float ps = 0;
#pragma unroll
  for (int r = 0; r < 16; ++r) ps += p0[r];
#pragma unroll
  for (int r = 0; r < 16; ++r) ps += p1[r];
  { auto rr = __builtin_amdgcn_permlane32_swap(__float_as_uint(ps), __float_as_uint(ps), false, false);
    ps = __uint_as_float(rr[0]) + __uint_as_float(rr[1]); }
  l_reg = l_reg * alpha + ps;
#pragma unroll
  for (int q = 0; q < 4; ++q) { int w0 = pa[q], w1 = pa[4 + q];
    w0 = __builtin_amdgcn_cvt_pk_fp8_f32(p0[4 * q], p0[4 * q + 1], w0, false); w0 = __builtin_amdgcn_cvt_pk_fp8_f32(p0[4 * q + 2], p0[4 * q + 3], w0, true);
    w1 = __builtin_amdgcn_cvt_pk_fp8_f32(p1[4 * q], p1[4 * q + 1], w1, false); w1 = __builtin_amdgcn_cvt_pk_fp8_f32(p1[4 * q + 2], p1[4 * q + 3], w1, true);
    pa[q] = w0; pa[4 + q] = w1; }
}
__device__ __forceinline__ int k8_off(int row, int c) { return row * DQK + (((c & ~3) | ((c & 3) ^ ((row >> 2) & 3))) << 4); }
__device__ __forceinline__ void qkt(f32x16& p0, f32x16& p1, const char* Ks, const v8i* qr, int r32, int hi, const f32x16& nm16) {
#pragma unroll
  for (int s = 0; s < 3; ++s) { const int c0 = 4 * s + 2 * hi;
    const v8i a0 = __builtin_shufflevector(*reinterpret_cast<const v4i*>(Ks + k8_off(r32, c0)), *reinterpret_cast<const v4i*>(Ks + k8_off(r32, c0 + 1)), 0, 1, 2, 3, 4, 5, 6, 7);
    const v8i a1 = __builtin_shufflevector(*reinterpret_cast<const v4i*>(Ks + 32 * DQK + k8_off(r32, c0)), *reinterpret_cast<const v4i*>(Ks + 32 * DQK + k8_off(r32, c0 + 1)), 0, 1, 2, 3, 4, 5, 6, 7);
    p0 = __builtin_amdgcn_mfma_scale_f32_32x32x64_f8f6f4(a0, qr[s], s == 0 ? nm16 : p0, 0, 0, 0, 0, 0, 0);
    p1 = __builtin_amdgcn_mfma_scale_f32_32x32x64_f8f6f4(a1, qr[s], s == 0 ? nm16 : p1, 0, 0, 0, 0, 0, 0); }
}
__device__ __forceinline__ void pv_d0(f32x16* o, const char* Vs, v8i pa, int r32, int hi) {
#pragma unroll
  for (int d0 = 0; d0 < 4; ++d0) { const int row = 32 * d0 + r32, x = (row >> 2) & 3;
    const v8i vb = __builtin_shufflevector(*reinterpret_cast<const v4i*>(Vs + row * 64 + (((2 * hi) ^ x) << 4)), *reinterpret_cast<const v4i*>(Vs + row * 64 + (((2 * hi + 1) ^ x) << 4)), 0, 1, 2, 3, 4, 5, 6, 7);
    o[d0] = __builtin_amdgcn_mfma_scale_f32_32x32x64_f8f6f4(pa, vb, o[d0], 0, 0, 0, 0, 0, 0); }
}
__device__ __forceinline__ void attn_unit(const unsigned char* __restrict__ CQt, const unsigned char* __restrict__ Wh, const f32x2* __restrict__ cst, const unsigned char* __restrict__ Kh, const unsigned char* __restrict__ Vh, bf16* __restrict__ Ob, char* lds) {
  int tid = threadIdx.x; asm volatile("" : "+v"(tid));
  const int wid = __builtin_amdgcn_readfirstlane(tid >> 6), lane = tid & 63, r32 = lane & 31, hi = lane >> 5;
#define VS(b) ((b) == 0 ? 0 : 24 * 1024 + (b) * SHM_V)
#define KS(b) ((b) == 0 ? 8 * 1024 : ((b) == 1 ? 20 * 1024 : 48 * 1024))
  constexpr int WIMG = 32 * 1024;
  float* wsp = (float*)(lds + 60 * 1024) + wid * 64; float* li_l = wsp; float* al_l = wsp + 32;
  float m_reg = 0.f, l_reg = 0; f32x16 o[4] = {}; v8i qr[3]; f32x16 nm16 = {};
  int koff[2], voff[2];
#pragma unroll
  for (int i = 0; i < 2; ++i) { const int m = (i * 8 + wid) * 64 + lane, row = m / 12, cp = m % 12; const int c = (cp & ~3) | ((cp & 3) ^ ((row >> 2) & 3)); koff[i] = row * DQK + c * 16; }
  { const int m = wid * 64 + lane, d = m >> 2, cp = m & 3; voff[0] = d * SEQ + ((cp ^ ((d >> 2) & 3)) << 4); voff[1] = 0; }
#define ADMA(t, b) do { __builtin_amdgcn_global_load_lds((const unsigned*)(Kh + (long)(t) * KVBLK * DQK + koff[0]), (LAS unsigned*)(LAS char*)(lds + KS(b) + wid * 1024), 16, 0, 0); \
    if (wid < 4) __builtin_amdgcn_global_load_lds((const unsigned*)(Kh + (long)(t) * KVBLK * DQK + koff[1]), (LAS unsigned*)(LAS char*)(lds + KS(b) + (8 + wid) * 1024), 16, 0, 0); \
    __builtin_amdgcn_global_load_lds((const unsigned*)(Vh + (long)(t) * KVBLK + voff[0]), (LAS unsigned*)(LAS char*)(lds + VS(b) + wid * 1024), 16, 0, 0); } while (0)
#define AWAIT(n) asm volatile("s_waitcnt vmcnt(" #n ")" ::: "memory")
#define ABAR() do { asm volatile("" ::: "memory"); __builtin_amdgcn_s_barrier(); asm volatile("" ::: "memory"); } while (0)
#define RESC(a) do { if (__any((a) < 1.f)) { if (hi == 0) al_l[r32] = (a); asm volatile("s_waitcnt lgkmcnt(0)" ::: "memory"); \
    _Pragma("unroll") for (int d = 0; d < 4; ++d) _Pragma("unroll") for (int r = 0; r < 16; ++r) o[d][r] *= al_l[crow(r, hi)]; } } while (0)
  f32x16 pA0, pA1, pB0, pB1; float alA, alB; v8i pa = {0, 0, 0, 0, 0, 0, 0, 0}; constexpr int NTL = SEQ / KVBLK;
#define ASTEP(X0, X1, alX, Y0, Y1, alY, jt, bp, bc, bn) do { \
    if ((jt) + 1 < NTL) ADMA((jt) + 1, bn); \
    SBAR(); qkt(X0, X1, lds + KS(bc), qr, r32, hi, nm16); \
    finishSM(Y0, Y1, alY, l_reg, pa); SBAR(); \
    pv_d0(o, lds + VS(bp), pa, r32, hi); partialSM<false>(X0, X1, m_reg, nm16, alX); \
    RESC(alX); \
    AWAIT(0); ABAR(); } while (0)
#define ASTEP_B(jt, bp, bc, bn) ASTEP(pB0, pB1, alB, pA0, pA1, alA, jt, bp, bc, bn)
#define ASTEP_A(jt, bp, bc, bn) ASTEP(pA0, pA1, alA, pB0, pB1, alB, jt, bp, bc, bn)
  {
#pragma unroll
    for (int i = 0; i < 12; ++i) { const int m = i * 512 + tid, row = m >> 5, cp = m & 31;
      __builtin_amdgcn_global_load_lds((const unsigned*)(Wh + (long)row * QL + ((cp ^ (row & 15)) << 4)), (LAS unsigned*)(LAS char*)(lds + WIMG + (i * 8 + wid) * 1024), 16, 0, 0); }
    ADMA(0, 0);
    const unsigned char* cq = CQt + (long)(wid * QBLK + r32) * QL + hi * 32;
    v8i cb[8];
#pragma unroll
    for (int ks = 0; ks < 8; ++ks) cb[ks] = *reinterpret_cast<const v8i*>(cq + ks * 64);
    const f32x2* csl = cst + (long)(wid * QBLK + r32) * 32 + 16 * hi;
    constexpr float QS = QSCALE / 32.0f;
    asm volatile("s_waitcnt vmcnt(0)" ::: "memory"); __builtin_amdgcn_s_barrier(); asm volatile("" ::: "memory");
    const int x15 = r32 & 15;
#pragma unroll
    for (int s3 = 0; s3 < 3; ++s3) {
      f32x16 a0 = {}, a1 = {};
      f32x2 cc[16];
      if (s3 == 2) {
#pragma unroll
        for (int r = 0; r < 16; ++r) cc[r] = csl[r]; }
      const char* w0 = lds + WIMG + (64 * s3 + r32) * QL; const char* w1 = w0 + 32 * QL;
#pragma unroll
      for (int ks = 0; ks < 8; ++ks) { const int c = ks * 4 + hi * 2;
        const v8i x0 = __builtin_shufflevector(*reinterpret_cast<const v4i*>(w0 + ((c ^ x15) << 4)), *reinterpret_cast<const v4i*>(w0 + (((c + 1) ^ x15) << 4)), 0, 1, 2, 3, 4, 5, 6, 7);
        const v8i x1 = __builtin_shufflevector(*reinterpret_cast<const v4i*>(w1 + ((c ^ x15) << 4)), *reinterpret_cast<const v4i*>(w1 + (((c + 1) ^ x15) << 4)), 0, 1, 2, 3, 4, 5, 6, 7);
        a0 = __builtin_amdgcn_mfma_scale_f32_32x32x64_f8f6f4(x0, cb[ks], a0, 0, 0, 0, 0, 0, 0);
        a1 = __builtin_amdgcn_mfma_scale_f32_32x32x64_f8f6f4(x1, cb[ks], a1, 0, 0, 0, 0, 0, 0); }
      if (s3 == 2) {
#pragma unroll
        for (int r = 0; r < 16; r += 2) { const f32x2 c0 = cc[r >> 1], c1 = cc[8 + (r >> 1)];
          const float x0 = a0[r], y0 = a0[r + 1], x1 = a1[r], y1 = a1[r + 1];
          a0[r] = x0 * c0.x - y0 * c0.y; a0[r + 1] = y0 * c0.x + x0 * c0.y; a1[r] = x1 * c1.x - y1 * c1.y; a1[r + 1] = y1 * c1.x + x1 * c1.y; } }
#pragma unroll
      for (int q = 0; q < 4; ++q) { int u0 = 0, u1 = 0;
        u0 = __builtin_amdgcn_cvt_pk_fp8_f32(a0[4 * q] * QS, a0[4 * q + 1] * QS, u0, false); u0 = __builtin_amdgcn_cvt_pk_fp8_f32(a0[4 * q + 2] * QS, a0[4 * q + 3] * QS, u0, true);
        u1 = __builtin_amdgcn_cvt_pk_fp8_f32(a1[4 * q] * QS, a1[4 * q + 1] * QS, u1, false); u1 = __builtin_amdgcn_cvt_pk_fp8_f32(a1[4 * q + 2] * QS, a1[4 * q + 3] * QS, u1, true);
        qr[s3][q] = u0; qr[s3][4 + q] = u1; }
    }
    asm volatile("s_waitcnt lgkmcnt(0)" ::: "memory"); __builtin_amdgcn_s_barrier(); asm volatile("" ::: "memory");
  }
  ADMA(1, 1);
  qkt(pA0, pA1, lds + KS(0), qr, r32, hi, nm16); partialSM<true>(pA0, pA1, m_reg, nm16, alA);
  AWAIT(0); ABAR();
  static_assert(NTL == 64, "step pattern below: tiles 1..60 in the loop, 61..63 after it");
#pragma nounroll
  for (int j = 1; j <= 55; j += 6) {
    ASTEP_B(j, 0, 1, 2); ASTEP_A(j + 1, 1, 2, 0); ASTEP_B(j + 2, 2, 0, 1);
    ASTEP_A(j + 3, 0, 1, 2); ASTEP_B(j + 4, 1, 2, 0); ASTEP_A(j + 5, 2, 0, 1);
  }
  ASTEP_B(61, 0, 1, 2); ASTEP_A(62, 1, 2, 0); ASTEP_B(63, 2, 0, 1);
  finishSM(pB0, pB1, alB, l_reg, pa); SBAR();
  pv_d0(o, lds + VS(0), pa, r32, hi);
#undef ASTEP_A
#undef ASTEP_B
  if (hi == 0) li_l[r32] = l_reg; asm volatile("s_waitcnt lgkmcnt(0)" ::: "memory");
  float rli[16];
#pragma unroll
  for (int r = 0; r < 16; ++r) rli[r] = __builtin_amdgcn_rcpf(li_l[crow(r, hi)]);
  bf16* Ow = FP8_WO ? (bf16*)((unsigned char*)Ob + (long)(wid * QBLK) * DM) : Ob + (long)(wid * QBLK) * DM;
#pragma unroll
  for (int r = 0; r < 16; r += 2) {
#pragma unroll
    for (int d0 = 0; d0 < 4; ++d0) {
      const float va = o[d0][r] * rli[r], vb = o[d0][r + 1] * rli[r + 1];
      const float snd = (lane & 1) ? va : vb; const float got = __shfl_xor(snd, 1);
      const int orow = (lane & 1) ? crow(r + 1, hi) : crow(r, hi); const int ocol = d0 * 32 + (r32 & ~1);
      if (FP8_WO) { const int w8 = (lane & 1) ? __builtin_amdgcn_cvt_pk_fp8_f32(got, vb, 0, false) : __builtin_amdgcn_cvt_pk_fp8_f32(va, got, 0, false);
        *(unsigned short*)((unsigned char*)Ow + (long)orow * DM + ocol) = (unsigned short)w8; }
      else { const unsigned w = (lane & 1) ? cvtpk(got, vb) : cvtpk(va, got); *(unsigned*)(Ow + (long)orow * DM + ocol) = w; } }
  }
  asm volatile("s_waitcnt lgkmcnt(0)" ::: "memory"); ABAR();
#undef ADMA
#undef VS
#undef KS
#undef AWAIT
#undef ABAR
#undef RESC
#undef ASTEP
}
#undef KSWZ
}

__device__ __forceinline__ void attn_phase(CArgs& A, unsigned char* lds, int l) {
    constexpr int G = 256;
    const unsigned char* Kb = A.ws + WS_K; const unsigned char* Vb = A.ws + WS_V; bf16* O = (bf16*)(A.ws + WS_O);
    constexpr int NQB = SEQ / 256, NU = NB * NH * NQB;
    const int c = blockIdx.x;
    for (int i = 0; i * G < NU; ++i) {
        int L;
        { const int x = c & 7, j = c >> 3; L = (i * 16 + x * 2 + (j >> 4)) * NQB + (j & 15); }
        if (L >= NU) break;
        const int bh = L / NQB, qb = L % NQB, b = bh / NH, h = bh % NH;
        att::attn_unit(A.ws + WS_CQN + ((size_t)b * SEQ + qb * 256) * QL, A.ws + WS_WUQ + ((size_t)l * NH * DQK + (size_t)h * DQK) * QL, (const f32x2*)(A.ws + WS_CS) + ((size_t)b * SEQ + qb * 256) * 32, Kb + (size_t)bh * SEQ * DQK, Vb + (size_t)bh * SEQ * DV, FP8_WO ? (bf16*)((unsigned char*)(A.ws + WS_O8) + ((size_t)b * SEQ + qb * 256) * DM + h * DV) : O + ((size_t)b * SEQ + qb * 256) * DM + h * DV, (char*)lds);
    }
}

__device__ __forceinline__ void combine_phase(CArgs& A, int l, const float* xin, LAS unsigned char* lds, int vcu, int G) {
    int tid = threadIdx.x; asm volatile("" : "+v"(tid));
    const int lane = tid & 63, wave = __builtin_amdgcn_readfirstlane(tid >> 6);
    const MoeTab T = moe_tables(A, l, lds, false);
    const unsigned* ASG = (const unsigned*)(A.ws + WS_ASG); const float* ASGW = (const float*)(A.ws + WS_ASG + 512 * 1024);
    const unsigned char* OUT2b = A.ws + WS_OUT2; float* X = (float*)(A.ws + WS_X); bf16* H = (bf16*)(A.ws + WS_H);
    const bool lastl = (l == DEPTH - 1);
    for (int t = vcu * NWAVES + wave; t < NT; t += G * NWAVES) {
        const int b = t / SEQ;
        Row x;
        const ModPtr gt = mod_ptr(A, l, b, 5);
#define CB_ISSUE(dst, k0) _Pragma("unroll") for (int k = 0; k < 2; ++k) { const unsigned pk_ = ASG[(size_t)t * 8 + (k0) + k]; const int e = pk_ >> 16, slot = pk_ & 0xffff; const unsigned char* p = OUT2b + ((size_t)T.ts[e] * 256 + slot) * DM + 1024 * hh; \
            _Pragma("unroll") for (int j = 0; j < 2; ++j) dst[k][j] = *(const u32x2*)(p + 512 * j + 8 * lane); }
#define CB_ACC(src, k0) _Pragma("unroll") for (int k = 0; k < 2; ++k) { const float w = ASGW[(size_t)t * 8 + (k0) + k]; \
            _Pragma("unroll") for (int j = 0; j < 2; ++j) { f32x4 a, c; unpack8_fp8(src[k][j], a, c); \
                y[j][0] += w * a.x; y[j][1] += w * a.y; y[j][2] += w * a.z; y[j][3] += w * a.w; y[j][4] += w * c.x; y[j][5] += w * c.y; y[j][6] += w * c.z; y[j][7] += w * c.w; } }
#pragma unroll
        for (int hh = 0; hh < 2; ++hh) {
            u32x2 rs[2], ra[2][2], rb[2][2]; float y[2][8];
            { const unsigned char* p = OUT2b + (size_t)(MAXROWS + t) * DM + 1024 * hh;
#pragma unroll
              for (int j = 0; j < 2; ++j) rs[j] = *(const u32x2*)(p + 512 * j + 8 * lane); }
            CB_ISSUE(ra, 0) CB_ISSUE(rb, 2)
            asm volatile("" ::: "memory");
#pragma unroll
            for (int j = 0; j < 2; ++j) { f32x4 a, c; unpack8_fp8(rs[j], a, c); y[j][0] = a.x; y[j][1] = a.y; y[j][2] = a.z; y[j][3] = a.w; y[j][4] = c.x; y[j][5] = c.y; y[j][6] = c.z; y[j][7] = c.w; }
            CB_ACC(ra, 0)
            asm volatile("" ::: "memory");
            CB_ISSUE(ra, 4)
            asm volatile("" ::: "memory");
            CB_ACC(rb, 2)
            asm volatile("" ::: "memory");
            CB_ISSUE(rb, 6)
            asm volatile("" ::: "memory");
            CB_ACC(ra, 4)
            asm volatile("" ::: "memory");
            f32x4 xv[2][2], gv[2][2];
#pragma unroll
            for (int j = 0; j < 2; ++j)
#pragma unroll
                for (int q4 = 0; q4 < 2; ++q4) { const int c = 1024 * hh + 512 * j + 8 * lane + 4 * q4; xv[j][q4] = *(const f32x4*)(xin + (size_t)t * DM + c); gv[j][q4] = *(const f32x4*)(gt.acc + c); }
            asm volatile("" ::: "memory");
            CB_ACC(rb, 6)
#pragma unroll
            for (int j = 0; j < 2; ++j)
#pragma unroll
                for (int q4 = 0; q4 < 2; ++q4)
#pragma unroll
                    for (int q = 0; q < 4; ++q) x.v[2 * hh + j][4 * q4 + q] = xv[j][q4][q] + gv[j][q4][q] * y[j][4 * q4 + q];
            asm volatile("" ::: "memory");
        }
#undef CB_ISSUE
#undef CB_ACC
        if (!lastl) {
            row_store_f32(x, X + (size_t)t * DM, lane);
            row_norm_mod_store(x, A.in[I_GMIX] + (size_t)(l + 1) * DM, mod_ptr(A, l + 1, b, 0), mod_ptr(A, l + 1, b, 1), H + (size_t)t * DM, lane, A.ws + WS_H8 + (size_t)t * DM);
        } else {
            const float rstd = row_rstd(x); const float* g = A.in[I_GFIN];
#pragma unroll
            for (int j = 0; j < 4; ++j)
#pragma unroll
                for (int q4 = 0; q4 < 2; ++q4) { const int c = 512 * j + 8 * lane + 4 * q4; const f32x4 gv = *(const f32x4*)(g + c);
#pragma unroll
                    for (int q = 0; q < 4; ++q) x.v[j][4 * q4 + q] = x.v[j][4 * q4 + q] * rstd * gv[q]; }
            row_store_f32(x, A.out + (size_t)t * DM, lane);
        }
    }
}

__device__ __forceinline__ CArgs* fresh_args() { CArgs* p = (CArgs*)__builtin_amdgcn_kernarg_segment_ptr(); asm volatile("" : "+s"(p)); return p; }
constexpr int NPH = 2 + 10 * DEPTH;
#ifndef KIND_MASK
#define KIND_MASK 0xfff
#endif
#define KEN(k) ((KIND_MASK >> (k)) & 1)
#ifndef REP_KIND
#define REP_KIND -1
#endif
#ifndef REP_N
#define REP_N 2
#endif
#define REP(k) for (int rep_ = 0; rep_ < ((REP_KIND == (k)) ? REP_N : 1); ++rep_)
#define IN(k) (fresh_args()->ph_lo <= (k) && (k) < fresh_args()->ph_hi)
#define SEAM(k) do { if (IN(k) && IN((k) + 1)) { XcdBarrier bar; bar.bar = (unsigned*)(fresh_args()->ws + WS_CTL) + CW_BAR; bar.x = xb_xcc_id(); bar.st = (volatile LAS unsigned*)(lds + LDS_TAB) + 8; xcd_barrier(bar); } } while (0)
#define PHASE_ARGS() CArgs* A_p = fresh_args(); CArgs& A = *A_p; unsigned char* ws = A.ws; (void)ws;
template <int l> __device__ __forceinline__ void layer_body(LAS unsigned char* lds, unsigned char* lds_raw, int bx, int vcu) {
    constexpr int G = 256;
        const int pb = 2 + 10 * l;
        if (KEN(2) && IN(pb + 0)) REP(2) { PHASE_ARGS();
            { WinP<EpiProj> P; P.A = (const char*)(ws + WS_H8); P.Bt = (const char*)(ws + WS_WIN8) + (size_t)l * NINP * DM; P.ord.init(NT / 256, NINP / 256, G, bx); P.e.P = (bf16*)(ws + WS_PROJ); P.e.isc = 1.0f / W13_SCALE; P.e.pn0 = 0;
              pg::gemm_phase(lds, P); }
        } SEAM(pb + 0);
        if (KEN(3) && IN(pb + 1)) REP(3) { PHASE_ARGS(); postproj_phase(A, l, vcu, G); } SEAM(pb + 1);
        if (KEN(4) && IN(pb + 2)) REP(4) { PHASE_ARGS();
            const auto mkK = [=]() { unsigned char* ws = fresh_args()->ws; DenseP<KVL, EpiK, pg::ListOrder> P; P.A = (const char*)(ws + WS_CKVN); P.Bt = (const char*)(ws + WS_WUKV) + (size_t)l * NH * 128 * KVL * 2; P.ord.nN = NH / 2; P.ord.first = bx; P.ord.n = 1; P.e.Kb = ws + WS_K; return P; };
            const auto mkV = [=]() { unsigned char* ws = fresh_args()->ws; DenseP<KVL, EpiVt, pg::ListOrder> P; P.A = (const char*)(ws + WS_WUKV + 2 * MiB) + (size_t)l * NH * 128 * KVL * 2; P.Bt = (const char*)(ws + WS_CKVN); P.ord.nN = NT / 256; P.ord.first = bx; P.ord.n = 1;
                                     P.e.Vt = ws + WS_V; return P; };
            { DenseP<CW, EpiConv> P; P.A = (const char*)(ws + WS_CZ); P.Bt = (const char*)(ws + WS_WCO) + (size_t)l * DM * CW * 2; P.ord.init(NT / 256, DM / 256, G, bx); P.e.P = (const bf16*)(ws + WS_PROJ); P.e.M1 = (bf16*)(ws + WS_M1);
              pg::gemm_phase(lds, P, mkK, true, false); }
            { const auto P = mkK(); pg::gemm_phase(lds, P, mkV, true, true); }
            { const auto P = mkV(); pg::gemm_phase(lds, P, pg::NoChain(), false, true); }
        } SEAM(pb + 2);
        if (KEN(5) && IN(pb + 3)) REP(5) { PHASE_ARGS(); attn_phase(A, lds_raw, l); } SEAM(pb + 3);
        if (KEN(6) && IN(pb + 4)) REP(6) { PHASE_ARGS();
#if FP8_WO
            WinP<EpiWo> P; P.A = (const char*)(ws + WS_O8); P.Bt = (const char*)(ws + WS_WO8) + (size_t)l * DM * DM; P.e.isc = 1.0f / W13_SCALE;
#else
            DenseP<DM, EpiWo> P; P.A = (const char*)(ws + WS_O); P.Bt = (const char*)(ws + WS_WO) + (size_t)l * DM * DM * 2; P.e.isc = 1.0f;
#endif
            P.ord.init(NT / 256, DM / 256, G, bx);
            P.e.P = (const bf16*)(ws + WS_PROJ); P.e.M1 = (const bf16*)(ws + WS_M1); P.e.MIX = (bf16*)(ws + WS_MIX); P.e.MIX8 = ws + WS_MIX8;
            pg::gemm_phase(lds, P);
        } SEAM(pb + 4);
        if (KEN(7) && IN(pb + 5)) REP(7) { PHASE_ARGS();
#if FP8_WOUT
            WinP<EpiWout> P; P.A = (const char*)(ws + WS_MIX8); P.Bt = (const char*)(ws + WS_WOUT8) + (size_t)l * DM * DM; P.e.isc = 1.0f / W13_SCALE;
#else
            DenseP<DM, EpiWout> P; P.A = (const char*)(ws + WS_MIX); P.Bt = (const char*)(ws + WS_WOUT) + (size_t)l * DM * DM * 2; P.e.isc = 1.0f;
#endif
            P.ord.init(NT / 256, DM / 256, G, bx);
            P.e.xin = (l == 0) ? A.in[I_X] : (const float*)(ws + WS_X); P.e.xout = (float*)(ws + WS_X); P.e.gacc = (const float*)(ws + WS_CTL) + CW_MOD + (size_t)l * NB * (NMOD * DM) + 2 * DM;
            pg::gemm_phase(lds, P);
        } SEAM(pb + 5);
        if (KEN(8) && IN(pb + 6)) { PHASE_ARGS(); nmr_phase(A, (const float*)(ws + WS_X), l, vcu, lds); } SEAM(pb + 6);
        if (KEN(9) && IN(pb + 7)) REP(9) { PHASE_ARGS();
            Moe1P P; P.H = (const char*)(ws + WS_H8); P.W = (const char*)(ws + WS_W13E) + (size_t)l * NE * 1024 * DM; P.WSH = (const char*)(ws + WS_WSH8) + (size_t)l * 1024 * DM; P.LIST = (const int*)(ws + WS_LIST); P.ACT = (bf16*)(ws + WS_ACT); P.SACT = (bf16*)(ws + WS_SACT); P.T = moe_tables(A, l, lds, true); P.G = G; P.c = bx;
            pg::gemm_phase(lds, P);
        } SEAM(pb + 7);
        if (KEN(10) && IN(pb + 8)) REP(10) { PHASE_ARGS();
            Moe2P P; P.ACT = (const char*)(ws + WS_ACT); P.SACT = (const char*)(ws + WS_SACT); P.W = (const char*)(ws + WS_W2E) + (size_t)l * NE * DM * DE; P.WS2 = (const char*)(ws + WS_W2S) + (size_t)l * DM * DS;
            P.OUT2 = (bf16*)(ws + WS_OUT2); P.T = moe_tables(A, l, lds, true); P.G = G; P.c = bx;
            pg::gemm_phase(lds, P);
        } SEAM(pb + 8);
        if (KEN(11) && IN(pb + 9)) REP(11) { PHASE_ARGS(); combine_phase(A, l, (const float*)(ws + WS_X), lds, vcu, G); } SEAM(pb + 9);
}
__global__ void __launch_bounds__(NTHREADS, 2) fwd_kernel(const Args A_unused) {
    extern __shared__ __attribute__((aligned(16))) unsigned char lds_raw[];
    LAS unsigned char* lds = (LAS unsigned char*)lds_raw;
    constexpr int G = 256;
    const int bx = blockIdx.x; const int vcu = (bx % 8) * (G / 8) + bx / 8;
    { volatile LAS unsigned* MISC = (volatile LAS unsigned*)(lds + LDS_TAB);
      const int t0 = otid(); if (t0 < 64) MISC[t0] = 0u;
      __syncthreads();
      CArgs* A0 = fresh_args();
      if (A0->ph_hi - A0->ph_lo > 1) (void)xcd_barrier_post((unsigned*)(A0->ws + WS_CTL) + CW_BAR, MISC + 8); }
    if (KEN(0) && IN(0)) REP(0) { PHASE_ARGS(); prologue_phase(A, lds, vcu, G); } SEAM(0);
    if (KEN(1) && IN(1)) REP(1) { PHASE_ARGS(); norm_mod_phase(A, A.in[I_X], A.in[I_GMIX], 0, 0, 1, vcu, G); } SEAM(1);
    layer_body<0>(lds, lds_raw, bx, vcu);
    layer_body<1>(lds, lds_raw, bx, vcu);
#undef IN
#undef SEAM
#undef PHASE_ARGS
}

#ifndef N_LAUNCH_MODE
#define N_LAUNCH_MODE 0
#endif
extern "C" void kernel_launch(void* const* d_in, const int* in_sizes, int n_in, void* d_out, int out_size, void* d_ws, size_t ws_size, hipStream_t stream) {
    static int grid = 0;
    if (grid == 0) {
        if (n_in != 25 || out_size != NT * DM || ws_size < WS_END) { fprintf(stderr, "kernel_launch: unexpected shapes: n_in %d out %d ws %zu (need %zu)\n", n_in, out_size, ws_size, (size_t)WS_END); grid = -1; return; }
        int dev = 0, cus = 0, per_cu = 0;
        if (hipGetDevice(&dev) != hipSuccess || hipDeviceGetAttribute(&cus, hipDeviceAttributeMultiprocessorCount, dev) != hipSuccess) { grid = -1; return; }
        if (hipFuncSetAttribute((const void*)fwd_kernel, hipFuncAttributeMaxDynamicSharedMemorySize, LDS_BYTES) != hipSuccess) { fprintf(stderr, "kernel_launch: hipFuncSetAttribute failed\n"); grid = -1; return; }
        if (hipOccupancyMaxActiveBlocksPerMultiprocessor(&per_cu, (const void*)fwd_kernel, NTHREADS, LDS_BYTES) != hipSuccess || per_cu < 1) { fprintf(stderr, "kernel_launch: occupancy query says %d\n", per_cu); }
        (void)hipGetLastError();
        if (cus != 256) fprintf(stderr, "kernel_launch: built for a 256-CU device, found %d CUs\n", cus);
        grid = 256;
    }
    if (grid < 0) return;
    (void)hipMemsetAsync((char*)d_ws + WS_CTL + (size_t)CW_BAR * 4, 0, (size_t)(CW_CNT + DEPTH * 64 - CW_BAR) * 4, stream);
    Args a{};
    for (int i = 0; i < 25; ++i) a.in[i] = (const float*)d_in[i];
    a.out = (float*)d_out; a.ws = (unsigned char*)d_ws;
#if N_LAUNCH_MODE == 0
    a.ph_lo = 0; a.ph_hi = NPH;
    hipLaunchKernelGGL(fwd_kernel, dim3(grid), dim3(NTHREADS), LDS_BYTES, stream, a);
#else
    for (int p = 0; p < NPH; ++p) { a.ph_lo = p; a.ph_hi = p + 1; hipLaunchKernelGGL(fwd_kernel, dim3(grid), dim3(NTHREADS), LDS_BYTES, stream, a); }
#endif
    const hipError_t le = hipPeekAtLastError();
    if (le != hipSuccess) fprintf(stderr, "kernel_launch: launch failed: %s\n", hipGetErrorName(le));
}
```
